# Optimizing an MI355X kernel written in HIP

```python
import jax, jax.numpy as jnp
from jax import lax
import numpy as np

D_MODEL = 1024
BATCH = 8
SEQ = 2048
DEPTH = 1
DEC_BATCH = 128
DEC_SEQ = 8
PAST_LEN = 16384
PAGE_SIZE = 128

N_META = 16
D_MIX = D_MODEL
D_A = D_MIX // 2
H_A = 4
DH_A = D_A // H_A
D_B = D_MIX - D_A
H_B = 4
DH_B = D_B // H_B
D_IN = 4 * D_A + 2 * H_A + 4 * D_B
D_FF = 2816
CONV_W = 3
CHUNK = 64
ALPHA = (2.0 * DEPTH) ** 0.25
BETA = (8.0 * DEPTH) ** -0.25
LN_EPS = 1e-5
RMS_EPS = 1e-6

kernel_name = 'hymba_mlstm_hgrn2_convffn_step'


def layer_norm(x, g, b):
    xf = x.astype(jnp.float32)
    mu = xf.mean(-1, keepdims=True)
    var = jnp.square(xf - mu).mean(-1, keepdims=True)
    return ((xf - mu) * lax.rsqrt(var + LN_EPS) * g + b).astype(x.dtype)


def head_rms(h, g):
    return h * lax.rsqrt(jnp.mean(h * h, -1, keepdims=True) + RMS_EPS) * g


def mlstm_chunk(carry, xs):
    C, n, m0 = carry
    q, k, v, ig, lf = xs
    T = q.shape[1]
    b = jnp.cumsum(lf, axis=1).transpose(0, 2, 1)
    igh = ig.transpose(0, 2, 1)
    causal = jnp.tril(jnp.ones((T, T), dtype=bool))
    D = jnp.where(causal, b[..., :, None] - b[..., None, :] + igh[..., None, :], -jnp.inf)
    m_t = jnp.maximum(b + m0[..., None], D.max(-1))
    dec = jnp.exp(b + m0[..., None] - m_t)
    W = jnp.exp(D - m_t[..., None])
    Sw = W * jnp.einsum('bthd,bshd->bhts', q, k)
    num = dec[..., None] * jnp.einsum('bthd,bhde->bhte', q, C) + jnp.einsum('bhts,bshe->bhte', Sw, v)
    den = dec * jnp.einsum('bthd,bhd->bht', q, n) + Sw.sum(-1)
    h = num / jnp.maximum(jnp.abs(den), jnp.exp(-m_t))[..., None]
    wT = W[:, :, -1, :]
    C_new = dec[..., -1, None, None] * C + jnp.einsum('bhs,bshd,bshe->bhde', wT, k, v)
    n_new = dec[..., -1, None] * n + jnp.einsum('bhs,bshd->bhd', wT, k)
    return (C_new, n_new, m_t[..., -1]), h.transpose(0, 2, 1, 3)


def hgrn_chunk(S, xs):
    q, lf, k, iv = xs
    T = q.shape[1]
    a = jnp.cumsum(lf, axis=1)
    causal = jnp.tril(jnp.ones((T, T), dtype=bool))[None, :, :, None, None]
    decay = jnp.exp(jnp.where(causal, a[:, :, None] - a[:, None, :], -jnp.inf))
    scores = jnp.einsum('bthc,btshc,bshc->bhts', q, decay, k)
    o = jnp.einsum('bthc,bhce->bthe', q * jnp.exp(a), S) + jnp.einsum('bhts,bshe->bthe', scores, iv)
    aT = a[:, -1]
    wk = jnp.exp(aT[:, None] - a) * k
    S_new = jnp.exp(aT)[..., None] * S + jnp.einsum('bshc,bshe->bhce', wk, iv)
    return S_new, o


def run_causal(fn, state, xs, lead):
    if lead is None:
        return fn(state, xs)
    state, out_head = fn(state, tuple(a[:, :lead] for a in xs))
    rest = tuple(a[:, lead:] for a in xs)
    Bn, L = rest[0].shape[0], rest[0].shape[1]
    n_c = L // CHUNK
    xs_c = tuple(jnp.moveaxis(a.reshape(Bn, n_c, CHUNK, *a.shape[2:]), 1, 0) for a in rest)
    state, outs = lax.scan(fn, state, xs_c)
    outs = jnp.moveaxis(outs, 0, 1).reshape(Bn, L, *outs.shape[3:])
    return state, jnp.concatenate([out_head, outs], axis=1)


def decoder_layer(x, lb, lead, mstate, hstate, conv_state, w_in, b_in, b_fgate_a, g_norm_a, g_norm_b,
                  w_out, b_out, ln1_g, ln1_b, w_up, b_up, w_conv, b_conv, w_down, b_down, ln2_g, ln2_b):
    Bn, T, _ = x.shape
    proj = (x @ w_in + b_in).astype(jnp.float32)
    splits = [int(s) for s in np.cumsum([D_A, D_A, D_A, D_A, H_A, H_A, D_B, D_B, D_B])]
    qa, ka, va, oa, ia, fa, qb, fb, ib, gb = jnp.split(proj, splits, axis=-1)
    hd = lambda t, H: t.reshape(Bn, T, H, -1)
    qa = hd(qa, H_A)
    ka = hd(ka, H_A) * (DH_A ** -0.5)
    va = hd(va, H_A)
    lfa = jax.nn.log_sigmoid(fa + b_fgate_a.astype(jnp.float32))
    mstate, h_a = run_causal(mlstm_chunk, mstate, (qa, ka, va, ia, lfa), lead)
    h_a = jax.nn.sigmoid(hd(oa, H_A)) * head_rms(h_a, g_norm_a.astype(jnp.float32))
    lbh = lb.reshape(H_B, DH_B)
    fb = hd(fb, H_B)
    lfb = jnp.log(lbh + (1.0 - lbh) * jax.nn.sigmoid(fb))
    kb = (1.0 - lbh) * jax.nn.sigmoid(-fb)
    qb = jax.nn.silu(hd(qb, H_B))
    ib = hd(ib, H_B)
    hstate, o_b = run_causal(hgrn_chunk, hstate, (qb, lfb, kb, ib), lead)
    h_b = jax.nn.sigmoid(hd(gb, H_B)) * head_rms(o_b, g_norm_b.astype(jnp.float32))
    mix = jnp.concatenate([h_a.reshape(Bn, T, D_A), h_b.reshape(Bn, T, D_B)], -1).astype(x.dtype)
    x = layer_norm(ALPHA * x + (mix @ w_out + b_out), ln1_g, ln1_b)
    up = x @ w_up + b_up
    u, gate = jnp.split(up, 2, axis=-1)
    full = jnp.concatenate([conv_state.astype(u.dtype), u], axis=1)
    conv = b_conv + full[:, 0:T] * w_conv[0]
    for j in range(1, CONV_W):
        conv = conv + full[:, j:j + T] * w_conv[j]
    new_conv = full[:, T:]
    ffn = (jax.nn.silu(conv) * gate) @ w_down + b_down
    x = layer_norm(ALPHA * x + ffn, ln2_g, ln2_b)
    return x, mstate, hstate, new_conv


def setup_inputs(seed: int = 0) -> dict:
    key = jax.random.key(seed)
    ks = jax.random.split(key, 32)
    nrm = lambda k, s, sc: jax.random.normal(k, s, jnp.float32) * sc
    f32 = jnp.float32
    return {
        'x_prompt': nrm(ks[0], (BATCH, SEQ, D_MODEL), 1.0),
        'x_sample': nrm(ks[1], (DEC_BATCH, DEC_SEQ, D_MODEL), 1.0),
        'state_mlstm_C': nrm(ks[2], (DEPTH, DEC_BATCH, H_A, DH_A, DH_A), 0.1),
        'state_mlstm_n': nrm(ks[3], (DEPTH, DEC_BATCH, H_A, DH_A), 0.5),
        'state_mlstm_m': nrm(ks[4], (DEPTH, DEC_BATCH, H_A), 1.0),
        'state_hgrn_S': nrm(ks[5], (DEPTH, DEC_BATCH, H_B, DH_B, DH_B), 0.1),
        'state_ffn_conv': nrm(ks[6], (DEPTH, DEC_BATCH, CONV_W - 1, D_FF), 1.0),
        'meta_tokens': nrm(ks[7], (N_META, D_MODEL), 1.0),
        'ln_emb_g': 1.0 + nrm(ks[8], (D_MODEL,), 0.02),
        'ln_emb_b': nrm(ks[9], (D_MODEL,), 0.02),
        'w_in': nrm(ks[10], (DEPTH, D_MODEL, D_IN), D_MODEL ** -0.5),
        'b_in': nrm(ks[11], (DEPTH, D_IN), 0.02),
        'b_fgate_a': jnp.broadcast_to(jnp.linspace(3.0, 6.0, H_A, dtype=f32), (DEPTH, H_A)) + nrm(ks[12], (DEPTH, H_A), 0.1),
        'g_norm_a': 1.0 + nrm(ks[13], (DEPTH, H_A, DH_A), 0.02),
        'g_norm_b': 1.0 + nrm(ks[14], (DEPTH, H_B, DH_B), 0.02),
        'hgrn_lb_logits': nrm(ks[15], (DEPTH + 1, D_B), 0.1),
        'w_out': nrm(ks[16], (DEPTH, D_MIX, D_MODEL), BETA * D_MIX ** -0.5),
        'b_out': nrm(ks[17], (DEPTH, D_MODEL), 0.02),
        'ln1_g': 1.0 + nrm(ks[18], (DEPTH, D_MODEL), 0.02),
        'ln1_b': nrm(ks[19], (DEPTH, D_MODEL), 0.02),
        'w_up': nrm(ks[20], (DEPTH, D_MODEL, 2 * D_FF), D_MODEL ** -0.5),
        'b_up': nrm(ks[21], (DEPTH, 2 * D_FF), 0.02),
        'w_conv': nrm(ks[22], (DEPTH, CONV_W, D_FF), CONV_W ** -0.5),
        'b_conv': nrm(ks[23], (DEPTH, D_FF), 0.02),
        'w_down': nrm(ks[24], (DEPTH, D_FF, D_MODEL), BETA * D_FF ** -0.5),
        'b_down': nrm(ks[25], (DEPTH, D_MODEL), 0.02),
        'ln2_g': 1.0 + nrm(ks[26], (DEPTH, D_MODEL), 0.02),
        'ln2_b': nrm(ks[27], (DEPTH, D_MODEL), 0.02),
    }


def reference(x_prompt, x_sample, state_mlstm_C, state_mlstm_n, state_mlstm_m, state_hgrn_S, state_ffn_conv,
              meta_tokens, ln_emb_g, ln_emb_b, w_in, b_in, b_fgate_a, g_norm_a, g_norm_b, hgrn_lb_logits,
              w_out, b_out, ln1_g, ln1_b, w_up, b_up, w_conv, b_conv, w_down, b_down, ln2_g, ln2_b):
    f32 = jnp.float32
    Bp = x_prompt.shape[0]
    lbs = jnp.cumsum(jax.nn.softmax(hgrn_lb_logits.astype(f32), axis=0), axis=0)
    meta = jnp.broadcast_to(meta_tokens[None].astype(x_prompt.dtype), (Bp, N_META, D_MODEL))
    xp = layer_norm(jnp.concatenate([meta, x_prompt], axis=1), ln_emb_g, ln_emb_b)
    xs = layer_norm(x_sample, ln_emb_g, ln_emb_b)
    Cp, np_, mp, Sp, cvp = [], [], [], [], []
    Cs, ns, ms, Ss, cvs = [], [], [], [], []
    for l in range(DEPTH):
        prm = (w_in[l], b_in[l], b_fgate_a[l], g_norm_a[l], g_norm_b[l], w_out[l], b_out[l], ln1_g[l], ln1_b[l],
               w_up[l], b_up[l], w_conv[l], b_conv[l], w_down[l], b_down[l], ln2_g[l], ln2_b[l])
        m0 = (jnp.zeros((Bp, H_A, DH_A, DH_A), f32), jnp.zeros((Bp, H_A, DH_A), f32), jnp.zeros((Bp, H_A), f32))
        h0 = jnp.zeros((Bp, H_B, DH_B, DH_B), f32)
        c0 = jnp.zeros((Bp, CONV_W - 1, D_FF), xp.dtype)
        xp, (c_p, n_p, m_p), s_p, cv_p = decoder_layer(xp, lbs[l], N_META, m0, h0, c0, *prm)
        ms0 = (state_mlstm_C[l].astype(f32), state_mlstm_n[l].astype(f32), state_mlstm_m[l].astype(f32))
        xs, (c_s, n_s, m_s), s_s, cv_s = decoder_layer(xs, lbs[l], None, ms0, state_hgrn_S[l].astype(f32),
                                                       state_ffn_conv[l], *prm)
        Cp.append(c_p); np_.append(n_p); mp.append(m_p); Sp.append(s_p); cvp.append(cv_p)
        Cs.append(c_s); ns.append(n_s); ms.append(m_s); Ss.append(s_s); cvs.append(cv_s)
    y_prompt = xp[:, N_META:]
    y_sample = xs
    return (y_prompt, y_sample,
            jnp.stack(Cp), jnp.stack(np_), jnp.stack(mp), jnp.stack(Sp), jnp.stack(cvp),
            jnp.stack(Cs), jnp.stack(ns), jnp.stack(ms), jnp.stack(Ss), jnp.stack(cvs))
```

```cpp
#include <hip/hip_runtime.h>
#include <hip/hip_cooperative_groups.h>
#include <cstdio>
#include <cstdint>
namespace cg = cooperative_groups;

#define LAS __attribute__((address_space(3)))
typedef unsigned short bf16_t;
typedef short bf16x8 __attribute__((ext_vector_type(8)));
typedef short s16x4 __attribute__((ext_vector_type(4)));
typedef float f32x4 __attribute__((ext_vector_type(4)));
typedef unsigned u32x4 __attribute__((ext_vector_type(4)));
typedef unsigned u32x2 __attribute__((ext_vector_type(2)));

constexpr int DM = 1024, NB = 8, SEQ = 2048, NMETA = 16, TP = SEQ + NMETA, DB = 128, DS = 8;
constexpr int RP = NB * TP;
constexpr int RS = DB * DS;
constexpr int MR = RP + RS;
constexpr int MP = 17664;
constexpr int DFF = 2816, DIN = 4104;
constexpr int NCH = 33;
constexpr int NSLOT = NB * 4 * NCH;
constexpr float ALPHA = 1.189207115002721f;
constexpr float LN_EPS = 1e-5f, RMS_EPS = 1e-6f;
constexpr float KSCALE = 0.08838834764831845f;

constexpr size_t MiB = 1u << 20;
constexpr size_t WS_WIN = 0, WS_WOUT = 8 * MiB, WS_WUP = 10 * MiB, WS_WDN = 21 * MiB;
constexpr size_t WS_SMALL = 27 * MiB;
constexpr size_t SM_STATS = 0;
constexpr size_t SM_IG = 160 * 1024;
constexpr size_t SM_LFA = SM_IG + 288 * 1024;
constexpr size_t SM_CHKL = SM_LFA + 288 * 1024;
constexpr size_t SM_CHKB = SM_CHKL + 8192;
constexpr size_t SM_MIN = SM_CHKB + 8192;
constexpr size_t SM_CHKN = SM_MIN + 8192;
constexpr size_t SM_NIN = SM_CHKN + 544 * 1024;
constexpr size_t SM_CHKA = SM_NIN + 544 * 1024;
constexpr size_t SM_BAR = SM_CHKA + 544 * 1024;
static_assert(SM_BAR + 16384 <= 4 * MiB, "small region");
constexpr size_t WS_BIG = 31 * MiB;
constexpr size_t SZ_R1024 = (size_t)MP * 1024 * 2;
constexpr size_t SZ_R512 = (size_t)MP * 512 * 2;
constexpr size_t SZ_CST = (size_t)NSLOT * 16384 * 2;
constexpr size_t WS_XN = WS_BIG, WS_CSTM = WS_BIG;
constexpr size_t WS_QAB = WS_BIG + SZ_R1024;
constexpr size_t WS_KA = WS_QAB + SZ_R1024, WS_VA = WS_KA + SZ_R512, WS_OA = WS_VA + SZ_R512, WS_IB = WS_OA + SZ_R512, WS_GB = WS_IB + SZ_R512;
constexpr size_t WS_FB = WS_GB + SZ_R512;
constexpr size_t WS_CSTH = WS_FB + SZ_R1024;
static_assert(WS_CSTH + SZ_CST <= 256 * MiB, "ws map (mixer)");
constexpr size_t WS_X1B = WS_BIG;
constexpr size_t WS_Z1 = WS_BIG + 2 * SZ_R1024;
constexpr size_t SZ_U = (size_t)MP * DFF * 2;
constexpr size_t WS_U = WS_BIG + SZ_R1024;
constexpr size_t WS_ACT = WS_U + SZ_U;
static_assert(WS_ACT + SZ_U <= 256 * MiB, "ws map (ffn)");

constexpr size_t O_YP = 0, O_CP = 17825792, O_NP = 18350080, O_MPR = 18354176, O_SP = 18354208, O_CVP = 18878496,
                 O_CS = 18923552, O_NS = 27312160, O_MS = 27377696, O_SS = 27378208, O_CVS = 35766816;

constexpr int LDS_BYTES = 155648;

struct Params { const float* in[28]; float* out; unsigned char* ws; };

typedef float f32x2_t __attribute__((ext_vector_type(2)));
typedef __bf16 bf16x2_t __attribute__((ext_vector_type(2)));
__device__ __forceinline__ unsigned pk2(float lo, float hi) { const f32x2_t v = {lo, hi}; const bf16x2_t b = __builtin_convertvector(v, bf16x2_t); return __builtin_bit_cast(unsigned, b); }
__device__ __forceinline__ unsigned f2bf(float f) { return pk2(f, 0.f) & 0xffffu; }
__device__ __forceinline__ float bflo(unsigned u) { return __uint_as_float(u << 16); }
__device__ __forceinline__ float bfhi(unsigned u) { return __uint_as_float(u & 0xffff0000u); }
__device__ __forceinline__ float bf2f(bf16_t h) { return __uint_as_float(((unsigned)h) << 16); }
__device__ __forceinline__ float wave_sum(float v) {
#pragma unroll
    for (int o = 1; o < 64; o <<= 1) v += __shfl_xor(v, o);
    return v;
}
__device__ __forceinline__ float frcp(float x) { return __builtin_amdgcn_rcpf(x); }
__device__ __forceinline__ float sigmoidf_(float x) { return frcp(1.0f + __expf(-x)); }
__device__ __forceinline__ float siluf_(float x) { return x * frcp(1.0f + __expf(-x)); }
__device__ __forceinline__ const float* xrow_ptr(const float* xp, const float* xs, const float* meta, int r) {
    if (r < RP) { const int b = r / TP, q = r - b * TP; return q < NMETA ? meta + (size_t)q * DM : xp + ((size_t)b * SEQ + (q - NMETA)) * DM; }
    return xs + (size_t)(r - RP) * DM;
}
typedef __attribute__((address_space(4))) const Params* KP;
__device__ __forceinline__ KP kparams() { KP k = (KP)__builtin_amdgcn_kernarg_segment_ptr(); asm volatile("" : "+s"(k)); return k; }
#define KIN(i) (kparams()->in[i])
#define KOUT() (kparams()->out)
#define KWS() (kparams()->ws)

namespace pg8 {
constexpr int BM = 256, BK = 64, HALF = 128, HTB = HALF * BK * 2, STAGE_BYTES = 8 * HTB, NXCD = 8, WGM = 8;
__host__ __device__ __forceinline__ int lds_byte(int r, int c) { const int st = (r >> 4) * 2 + (c >> 5), rr = r & 15, cc = c & 31, ob = rr * 64 + cc * 2; return st * 1024 + (ob ^ (((ob >> 9) & 1) << 5)); }
__host__ __device__ __forceinline__ void stage_rc(int b, int& R, int& C) { const int st = b / 1024, sb = b % 1024, swz = sb ^ (((sb >> 9) & 1) << 5); R = (st >> 1) * 16 + swz / 64; C = (st & 1) * 32 + (swz % 64) / 2; }
__host__ __device__ __forceinline__ int perm32(int rho) { const int n = rho >> 4, i = rho & 15; return 8 * (i >> 2) + 4 * n + (i & 3); }
struct Unit { int pm, pn, k0, nk, split; };
struct Gemm { const bf16_t* A; const bf16_t* Bt; int M, N, K; };
struct StaticOrder {
    int nM, nN, nwg, G, c, ntk;
    __host__ __device__ void init(int M, int N, int G_, int c_, int K_ = 1024) { nM = M / BM; nN = N / BM; nwg = nM * nN; G = G_; c = c_; ntk = K_ / BK; }
    __host__ __device__ bool next(int i, Unit& u) const {
        u.k0 = 0; u.nk = ntk; u.split = 0;
        const long L = (long)i * G + c; if (L >= nwg) return false;
        int wgid = (int)L; { const int q = nwg / NXCD, r = nwg % NXCD, xcd = wgid % NXCD, off = wgid / NXCD; wgid = (xcd < r ? xcd * (q + 1) : r * (q + 1) + (xcd - r) * q) + off; }
        const int nig = WGM * nN, gid = wgid / nig, fm = gid * WGM, gsz = (nM - fm) < WGM ? (nM - fm) : WGM;
        u.pm = fm + ((wgid % nig) % gsz); u.pn = (wgid % nig) / gsz; return true;
    }
    __device__ __forceinline__ void a_ready(const Unit&) const {}
    __device__ __forceinline__ void done(const Unit&) const {}
};
__host__ __device__ __forceinline__ void map_unit(int wgid, int nM, int nN, int nwg, Unit& u) {
    { const int q = nwg / NXCD, r = nwg % NXCD, xcd = wgid % NXCD, off = wgid / NXCD; wgid = (xcd < r ? xcd * (q + 1) : r * (q + 1) + (xcd - r) * q) + off; }
    const int nig = WGM * nN, gid = wgid / nig, fm = gid * WGM, gsz = (nM - fm) < WGM ? (nM - fm) : WGM;
    u.pm = fm + ((wgid % nig) % gsz); u.pn = (wgid % nig) / gsz;
}
struct TailSplitOrder {
    int nM, nN, nwg, G, c, ntk, S, split_mode, nMf;
    __host__ __device__ __forceinline__ void init(int M, int N, int G_, int c_, int K_, int S_) {
        nM = M / BM; nN = N / BM; nwg = nM * nN; G = G_; c = c_; ntk = K_ / BK; S = S_; nMf = G_ / nN;
        const int R = nwg - G_;
        split_mode = (G_ % nN == 0) && R > 0 && R * S_ <= G_ && (ntk % (2 * S_) == 0);
    }
    __host__ __device__ __forceinline__ int tail_row0() const { return split_mode ? nMf * BM : (1 << 30); }
    __host__ __device__ __forceinline__ bool next(int i, Unit& u) const {
        u.k0 = 0; u.nk = ntk; u.split = 0;
        if (!split_mode) { const long L = (long)i * G + c; if (L >= nwg) return false; map_unit((int)L, nM, nN, nwg, u); return true; }
        if (i == 0) { map_unit(c, nMf, nN, G, u); return true; }
        if (i > 1) return false;
        const int R = nwg - G; if (c >= R * S) return false;
        const int t = c / S, piece = c - t * S;
        u.pm = nMf + t / nN; u.pn = t % nN; u.nk = ntk / S; u.k0 = piece * u.nk; u.split = piece + 1; return true;
    }
    __device__ __forceinline__ void a_ready(const Unit&) const {}
    __device__ __forceinline__ void done(const Unit&) const {}
};
__device__ __forceinline__ void atomic_add4(float* o, const f32x4 v) {
#pragma unroll
    for (int j = 0; j < 4; ++j) __hip_atomic_fetch_add(o + j, v[j], __ATOMIC_RELAXED, __HIP_MEMORY_SCOPE_AGENT);
}
__device__ __forceinline__ unsigned cvt_pk_bf16(float lo, float hi) { unsigned r; asm volatile("v_cvt_pk_bf16_f32 %0, %1, %2" : "=v"(r) : "v"(lo), "v"(hi)); return r; }

template <class Epi, class Sched, bool ALIGN_EPI = false, bool SP2 = false>
__device__ __forceinline__ void gemm_phase(LAS unsigned char* lds, const Gemm g, const Sched& S, const Epi& E) {
    int tid_l = threadIdx.x; asm volatile("" : "+v"(tid_l));
    const int tid = tid_l, wid = __builtin_amdgcn_readfirstlane(tid >> 6), lane = tid & 63, wr = wid >> 2, wc = wid & 3, fr = lane & 15, fq = lane >> 4;
    const int K = g.K;
    unsigned voffA[2], voffB[2];
#pragma unroll
    for (int i = 0; i < 2; ++i) { int R, C; stage_rc(tid * 16 + i * 8192, R, C); const int Rb = Epi::PERM ? ((R & ~31) + perm32(R & 31)) : R;
        voffA[i] = (unsigned)(R * K + C) * 2u; voffB[i] = (unsigned)(Rb * K + C) * 2u; }
    const size_t kstep = (size_t)(BK * 2);
    const size_t hstep = (size_t)HALF * K * 2;
    const size_t tstep = 2 * hstep;
    const unsigned ldsw = (unsigned)wid * 1024u;
    const int aoff = lds_byte(wr * 64 + fr, fq * 8), boff = lds_byte(wc * 32 + fr, fq * 8);
#define PG8_SA(b, h) (((b) * 2 + (h)) * HTB)
#define PG8_SB(b, h) ((4 + (b) * 2 + (h)) * HTB)
#define PG8_STAGE(bufoff, gbase, voff) do { _Pragma("unroll") for (int _i = 0; _i < 2; ++_i) \
        __builtin_amdgcn_global_load_lds((const unsigned*)((const char*)(gbase) + (voff)[_i]), (LAS unsigned*)(lds + (bufoff) + ldsw + _i * 8192), 16, 0, 0); } while (0)
#define PG8_LDA(dst, b, h) do { _Pragma("unroll") for (int m = 0; m < 4; ++m) _Pragma("unroll") for (int k = 0; k < 2; ++k) dst[m][k] = *(const LAS bf16x8*)(lds + PG8_SA(b, h) + aoff + m * 2048 + k * 1024); } while (0)
#define PG8_LDB(dst, b, h) do { _Pragma("unroll") for (int n = 0; n < 2; ++n) _Pragma("unroll") for (int k = 0; k < 2; ++k) dst[n][k] = *(const LAS bf16x8*)(lds + PG8_SB(b, h) + boff + n * 2048 + k * 1024); } while (0)
#define PG8_MMA(ai, bj, At, Bt) do { __builtin_amdgcn_s_setprio(1); _Pragma("unroll") for (int m = 0; m < 4; ++m) _Pragma("unroll") for (int n = 0; n < 2; ++n) _Pragma("unroll") for (int k = 0; k < 2; ++k) \
        acc[ai][bj][m][n] = __builtin_amdgcn_mfma_f32_16x16x32_bf16(Bt[n][k], At[m][k], acc[ai][bj][m][n], 0, 0, 0); __builtin_amdgcn_s_setprio(0); } while (0)
#define PG8_WAIT_V(n) asm volatile("s_waitcnt vmcnt(" #n ")" ::: "memory")
#define PG8_WAIT_L(n) asm volatile("s_waitcnt lgkmcnt(" #n ")" ::: "memory")
#define PG8_BAR __builtin_amdgcn_s_barrier()
#define PG8_SCHED __builtin_amdgcn_sched_barrier(0)
    Unit cur, nxt; int ui = 0;
    if (!S.next(0, cur)) return;
    f32x4 acc[2][2][4][2];
#pragma unroll
    for (int a = 0; a < 2; ++a)
#pragma unroll
        for (int b = 0; b < 2; ++b)
#pragma unroll
            for (int m = 0; m < 4; ++m)
#pragma unroll
                for (int n = 0; n < 2; ++n) acc[a][b][m][n] = (f32x4){0.f, 0.f, 0.f, 0.f};
    bf16x8 At[4][2], B0[2][2], B1[2][2];
    const char* cA = (const char*)g.A + (size_t)cur.pm * tstep + (size_t)cur.k0 * kstep; const char* cB = (const char*)g.Bt + (size_t)cur.pn * tstep + (size_t)cur.k0 * kstep;
    S.a_ready(cur);
    if constexpr (SP2) {
        PG8_STAGE(PG8_SB(0, 0), cB, voffB); PG8_STAGE(PG8_SB(0, 1), cB + hstep, voffB); PG8_STAGE(PG8_SA(0, 0), cA, voffA); PG8_STAGE(PG8_SA(0, 1), cA + hstep, voffA);
        if (wr == 1) PG8_BAR;
        PG8_WAIT_V(2); PG8_BAR;
        PG8_STAGE(PG8_SB(1, 0), cB + kstep, voffB); PG8_STAGE(PG8_SA(1, 0), cA + kstep, voffA); PG8_STAGE(PG8_SB(1, 1), cB + hstep + kstep, voffB);
        PG8_WAIT_V(6); PG8_BAR;
    } else {
        PG8_STAGE(PG8_SB(0, 0), cB, voffB); PG8_STAGE(PG8_SA(0, 0), cA, voffA); PG8_STAGE(PG8_SB(0, 1), cB + hstep, voffB); PG8_STAGE(PG8_SA(0, 1), cA + hstep, voffA);
        if (wr == 1) PG8_BAR;
        PG8_WAIT_V(4); PG8_BAR;
        PG8_STAGE(PG8_SB(1, 0), cB + kstep, voffB); PG8_STAGE(PG8_SA(1, 0), cA + kstep, voffA); PG8_STAGE(PG8_SB(1, 1), cB + hstep + kstep, voffB);
        PG8_WAIT_V(6); PG8_BAR;
    }
    for (;;) {
        const bool has_next = S.next(ui + 1, nxt);
        const char* nA = has_next ? (const char*)g.A + (size_t)nxt.pm * tstep + (size_t)nxt.k0 * kstep : cA; const char* nB = has_next ? (const char*)g.Bt + (size_t)nxt.pn * tstep + (size_t)nxt.k0 * kstep : cB;
        const int nt = cur.nk;
        for (int t = 0; t < nt; t += 2) {
            const bool last = (t == nt - 2);
            const char* a1 = cA + (size_t)(t + 1) * kstep;
            const char* a2 = last ? nA : cA + (size_t)(t + 2) * kstep; const char* b2 = last ? nB : cB + (size_t)(t + 2) * kstep;
            const char* a3 = a2 + kstep; const char* b3 = b2 + kstep;
            if (last && has_next) S.a_ready(nxt);
            if constexpr (SP2) {
            PG8_LDB(B0, 0, 0); PG8_LDB(B1, 0, 1); PG8_SCHED; PG8_LDA(At, 0, 0); PG8_STAGE(PG8_SA(1, 1), a1 + hstep, voffA);
            PG8_WAIT_V(8); PG8_WAIT_L(0); PG8_BAR; PG8_MMA(0, 0, At, B0); PG8_MMA(0, 1, At, B1); PG8_BAR; PG8_SCHED;
            PG8_LDA(At, 0, 1); PG8_STAGE(PG8_SB(0, 0), b2, voffB); PG8_STAGE(PG8_SB(0, 1), b2 + hstep, voffB); PG8_STAGE(PG8_SA(0, 0), a2, voffA);
            PG8_WAIT_V(8); PG8_WAIT_L(0); PG8_BAR; PG8_MMA(1, 0, At, B0); PG8_MMA(1, 1, At, B1); PG8_BAR; PG8_SCHED;
            PG8_LDB(B0, 1, 0); PG8_LDB(B1, 1, 1); PG8_SCHED; PG8_LDA(At, 1, 0); PG8_STAGE(PG8_SA(0, 1), a2 + hstep, voffA);
            PG8_WAIT_V(8); PG8_WAIT_L(0); PG8_BAR; PG8_MMA(0, 0, At, B0); PG8_MMA(0, 1, At, B1); PG8_BAR; PG8_SCHED;
            PG8_LDA(At, 1, 1); PG8_STAGE(PG8_SB(1, 0), b3, voffB); PG8_STAGE(PG8_SB(1, 1), b3 + hstep, voffB); PG8_STAGE(PG8_SA(1, 0), a3, voffA);
            PG8_WAIT_V(8); PG8_WAIT_L(0); PG8_BAR; PG8_MMA(1, 0, At, B0); PG8_MMA(1, 1, At, B1); PG8_BAR; PG8_SCHED;
            } else {
            PG8_LDB(B0, 0, 0); PG8_SCHED; PG8_LDA(At, 0, 0); PG8_STAGE(PG8_SA(1, 1), a1 + hstep, voffA);
            PG8_WAIT_L(8); PG8_BAR; PG8_WAIT_L(0); PG8_MMA(0, 0, At, B0); PG8_BAR; PG8_SCHED;
            PG8_LDB(B1, 0, 1); PG8_STAGE(PG8_SB(0, 0), b2, voffB);
            PG8_BAR; PG8_WAIT_L(0); PG8_MMA(0, 1, At, B1); PG8_BAR;
            PG8_LDA(At, 0, 1); PG8_STAGE(PG8_SA(0, 0), a2, voffA);
            PG8_BAR; PG8_WAIT_L(0); PG8_MMA(1, 0, At, B0); PG8_BAR; PG8_SCHED;
            PG8_STAGE(PG8_SB(0, 1), b2 + hstep, voffB);
            PG8_WAIT_V(6); PG8_BAR; PG8_MMA(1, 1, At, B1); PG8_BAR;
            PG8_LDB(B0, 1, 0); PG8_SCHED; PG8_LDA(At, 1, 0); PG8_STAGE(PG8_SA(0, 1), a2 + hstep, voffA);
            PG8_WAIT_L(8); PG8_BAR; PG8_WAIT_L(0); PG8_MMA(0, 0, At, B0); PG8_BAR; PG8_SCHED;
            PG8_LDB(B1, 1, 1); PG8_STAGE(PG8_SB(1, 0), b3, voffB);
            PG8_BAR; PG8_WAIT_L(0); PG8_MMA(0, 1, At, B1); PG8_BAR;
            PG8_LDA(At, 1, 1); PG8_STAGE(PG8_SA(1, 0), a3, voffA);
            PG8_BAR; PG8_WAIT_L(0); PG8_MMA(1, 0, At, B0); PG8_BAR; PG8_SCHED;
            PG8_STAGE(PG8_SB(1, 1), b3 + hstep, voffB);
            PG8_WAIT_V(6); PG8_BAR; PG8_MMA(1, 1, At, B1); PG8_BAR;
            }
        }
        if constexpr (ALIGN_EPI) { if (wr == 0) PG8_BAR; }
        E(acc, cur, wr, wc, fr, fq);
        if (!has_next) break;
#pragma unroll
        for (int a = 0; a < 2; ++a)
#pragma unroll
            for (int b = 0; b < 2; ++b)
#pragma unroll
                for (int m = 0; m < 4; ++m)
#pragma unroll
                    for (int n = 0; n < 2; ++n) acc[a][b][m][n] = (f32x4){0.f, 0.f, 0.f, 0.f};
        cur = nxt; cA = nA; cB = nB; ++ui;
        if constexpr (ALIGN_EPI) { if (wr == 1) PG8_BAR; }
    }
    PG8_WAIT_V(0);
    if constexpr (!ALIGN_EPI) { if (wr == 0) PG8_BAR; }
    PG8_BAR;
#undef PG8_SA
#undef PG8_SB
#undef PG8_STAGE
#undef PG8_LDA
#undef PG8_LDB
#undef PG8_MMA
#undef PG8_WAIT_V
#undef PG8_WAIT_L
#undef PG8_BAR
#undef PG8_SCHED
}

typedef f32x4 Acc[2][2][4][2];
constexpr size_t PART_STRIDE = (size_t)1280 * 1024;

struct EpiIn {
    static constexpr bool PERM = true;
    unsigned char* ws; const float* b_in;
    __device__ __forceinline__ void operator()(const Acc& acc, const Unit& u, int wr, int wc, int fr, int fq) const {
        const int g = u.pn >> 1;
        const int cg0 = (u.pn & 1) * 256 + wc * 32 + 8 * fq;
        const int bsrc0 = u.pn * 256 + wc * 32 + 8 * fq + (u.pn >= 8 ? 8 : 0);
        const int row0 = u.pm * BM + wr * 64 + fr;
        int mode = 0; size_t ld = 512; unsigned char* base;
        switch (g) {
            case 0: base = ws + WS_QAB; ld = 1024; break;
            case 1: base = ws + WS_KA; mode = 1; break;
            case 2: base = ws + WS_VA; break;
            case 3: base = ws + WS_OA; mode = 3; break;
            case 4: base = ws + WS_QAB + 1024; ld = 1024; mode = 2; break;
            case 5: base = ws + WS_FB; mode = 4; break;
            case 6: base = ws + WS_IB; break;
            default: base = ws + WS_GB; mode = 3; break;
        }
#pragma unroll
        for (int bj = 0; bj < 2; ++bj) {
            const f32x4 b0 = *(const f32x4*)(b_in + bsrc0 + bj * HALF), b1 = *(const f32x4*)(b_in + bsrc0 + bj * HALF + 4);
#pragma unroll
            for (int ai = 0; ai < 2; ++ai)
#pragma unroll
                for (int m = 0; m < 4; ++m) {
                    const size_t row = (size_t)(row0 + ai * HALF + m * 16);
                    f32x4 v0 = acc[ai][bj][m][0] + b0, v1 = acc[ai][bj][m][1] + b1;
                    if (mode == 4) { float* o = (float*)base + row * 512 + cg0 + bj * HALF; *(f32x4*)o = v0; *(f32x4*)(o + 4) = v1; continue; }
                    if (mode == 1) { v0 = v0 * KSCALE; v1 = v1 * KSCALE; }
                    else if (mode == 2) {
#pragma unroll
                        for (int j = 0; j < 4; ++j) { v0[j] = siluf_(v0[j]); v1[j] = siluf_(v1[j]); } }
                    else if (mode == 3) {
#pragma unroll
                        for (int j = 0; j < 4; ++j) { v0[j] = sigmoidf_(v0[j]); v1[j] = sigmoidf_(v1[j]); } }
                    u32x4 w; w.x = cvt_pk_bf16(v0[0], v0[1]); w.y = cvt_pk_bf16(v0[2], v0[3]); w.z = cvt_pk_bf16(v1[0], v1[1]); w.w = cvt_pk_bf16(v1[2], v1[3]);
                    *(u32x4*)((bf16_t*)base + row * ld + cg0 + bj * HALF) = w;
                }
        }
    }
};

struct EpiZ1 {
    static constexpr bool PERM = true;
    const float* xp; const float* xs; const float* meta; const float* gg; const float* gb; const float* bo; const float* stats; float* z1; float* tail; int tailrow0;
    __device__ __forceinline__ void operator()(const Acc& acc, const Unit& u, int wr, int wc, int fr, int fq) const {
        const int col0 = u.pn * BM + wc * 32 + 8 * fq;
#pragma unroll
        for (int bj = 0; bj < 2; ++bj) {
            const int col = col0 + bj * HALF;
            const f32x4 g0 = *(const f32x4*)(gg + col), g1 = *(const f32x4*)(gg + col + 4);
            const f32x4 c0 = *(const f32x4*)(gb + col) * ALPHA + *(const f32x4*)(bo + col), c1 = *(const f32x4*)(gb + col + 4) * ALPHA + *(const f32x4*)(bo + col + 4);
#pragma unroll
            for (int am = 0; am < 2; ++am) { const int ai = am, mb = 0;
                f32x4 xa[4], xb[4]; float mus[4], rss[4];
#pragma unroll
                for (int mm = 0; mm < 4; ++mm) { const int row = u.pm * BM + ai * HALF + wr * 64 + (mb + mm) * 16 + fr;
                    xa[mm] = (f32x4){0.f, 0.f, 0.f, 0.f}; xb[mm] = xa[mm]; mus[mm] = 0.f; rss[mm] = 0.f;
                    if (row < MR && u.split <= 1) { const float* xr = xrow_ptr(xp, xs, meta, row) + col; xa[mm] = *(const f32x4*)xr; xb[mm] = *(const f32x4*)(xr + 4); mus[mm] = stats[2 * row]; rss[mm] = stats[2 * row + 1] * ALPHA; } }
#pragma unroll
                for (int mm = 0; mm < 4; ++mm) { const int m = mb + mm;
                    const int row = u.pm * BM + ai * HALF + wr * 64 + m * 16 + fr;
                    f32x4 v0 = (f32x4){0.f, 0.f, 0.f, 0.f}, v1 = v0;
                    if (row < MR) {
                        v0 = acc[ai][bj][m][0]; v1 = acc[ai][bj][m][1];
                        if (u.split <= 1) { v0 = v0 + c0 + (xa[mm] - mus[mm]) * rss[mm] * g0; v1 = v1 + c1 + (xb[mm] - mus[mm]) * rss[mm] * g1; }
                    }
                    float* o = (u.split ? tail + (size_t)(u.split - 1) * PART_STRIDE + (size_t)(row - tailrow0) * DM : z1 + (size_t)row * DM) + col;
                    *(f32x4*)o = v0; *(f32x4*)(o + 4) = v1;
                }
            }
        }
    }
};

struct EpiU {
    static constexpr bool PERM = true;
    bf16_t* U; const float* b_up; float* out;
    __device__ __forceinline__ void operator()(const Acc& acc, const Unit& u, int wr, int wc, int fr, int fq) const {
        const int col0 = u.pn * BM + wc * 32 + 8 * fq;
#pragma unroll
        for (int bj = 0; bj < 2; ++bj) {
            const int col = col0 + bj * HALF;
            const f32x4 b0 = *(const f32x4*)(b_up + col), b1 = *(const f32x4*)(b_up + col + 4);
#pragma unroll
            for (int ai = 0; ai < 2; ++ai)
#pragma unroll
                for (int m = 0; m < 4; ++m) {
                    const int row = u.pm * BM + ai * HALF + wr * 64 + m * 16 + fr;
                    const f32x4 v0 = acc[ai][bj][m][0] + b0, v1 = acc[ai][bj][m][1] + b1;
                    u32x4 w; w.x = cvt_pk_bf16(v0[0], v0[1]); w.y = cvt_pk_bf16(v0[2], v0[3]); w.z = cvt_pk_bf16(v1[0], v1[1]); w.w = cvt_pk_bf16(v1[2], v1[3]);
                    *(u32x4*)(U + (size_t)row * DFF + col) = w;
                    float* o = nullptr;
                    if (row < RP) { const int b = row / TP, q = row - b * TP; if (q >= TP - 2) o = out + O_CVP + ((size_t)(b * 2 + (q - (TP - 2)))) * DFF + col; }
                    else if (row < MR) { const int s = row - RP, t = s & 7; if (t >= 6) o = out + O_CVS + ((size_t)((s >> 3) * 2 + (t - 6))) * DFF + col; }
                    if (o) { *(f32x4*)o = v0; *(f32x4*)(o + 4) = v1; }
                }
        }
    }
};

__device__ __forceinline__ void unpack8(const u32x4 w, f32x4& a, f32x4& b) { a = (f32x4){bflo(w.x), bfhi(w.x), bflo(w.y), bfhi(w.y)}; b = (f32x4){bflo(w.z), bfhi(w.z), bflo(w.w), bfhi(w.w)}; }
struct EpiAct {
    static constexpr bool PERM = true;
    const bf16_t* U; bf16_t* ACT; const float* b_upg; const float* w_conv; const float* b_conv; const float* cstate;
    __device__ __forceinline__ void operator()(const Acc& acc, const Unit& u, int wr, int wc, int fr, int fq) const {
        const int col0 = u.pn * BM + wc * 32 + 8 * fq;
#pragma unroll
        for (int bj = 0; bj < 2; ++bj) {
            const int col = col0 + bj * HALF;
            const f32x4 bg0 = *(const f32x4*)(b_upg + col), bg1 = *(const f32x4*)(b_upg + col + 4);
            const f32x4 bc0 = *(const f32x4*)(b_conv + col), bc1 = *(const f32x4*)(b_conv + col + 4);
            const f32x4 wa0 = *(const f32x4*)(w_conv + col), wa1 = *(const f32x4*)(w_conv + col + 4);
            const f32x4 wb0 = *(const f32x4*)(w_conv + DFF + col), wb1 = *(const f32x4*)(w_conv + DFF + col + 4);
            const f32x4 wc0 = *(const f32x4*)(w_conv + 2 * DFF + col), wc1 = *(const f32x4*)(w_conv + 2 * DFF + col + 4);
#pragma unroll
            for (int am = 0; am < 4; ++am) { const int ai = am >> 1, mb = (am & 1) * 2;
                u32x4 r0v[2], r1v[2], r2v[2];
#pragma unroll
                for (int mm = 0; mm < 2; ++mm) { const int m = mb + mm;
                    const int row = u.pm * BM + ai * HALF + wr * 64 + m * 16 + fr;
                    int t = 2;
                    if (row < RP) { const int b = row / TP; t = row - b * TP; } else if (row < MR) t = (row - RP) & 7;
                    const bf16_t* up = U + (size_t)row * DFF + col;
                    r0v[mm] = *(const u32x4*)up;
                    r1v[mm] = (u32x4){0u, 0u, 0u, 0u}; r2v[mm] = r1v[mm];
                    if (t >= 1) r1v[mm] = *(const u32x4*)(up - DFF);
                    if (t >= 2) r2v[mm] = *(const u32x4*)(up - 2 * DFF);
                }
#pragma unroll
                for (int mm = 0; mm < 2; ++mm) { const int m = mb + mm;
                    const int row = u.pm * BM + ai * HALF + wr * 64 + m * 16 + fr;
                    f32x4 u00, u01, u10, u11, u20, u21;
                    unpack8(r0v[mm], u00, u01); unpack8(r1v[mm], u10, u11); unpack8(r2v[mm], u20, u21);
                    if (row >= RP && row < MR) { const int s = row - RP, t = s & 7;
                        if (t < 2) { const float* cs = cstate + (size_t)(s >> 3) * 2 * DFF + col;
                            const float* c2 = cs + (t == 1 ? DFF : 0); u20 = *(const f32x4*)c2; u21 = *(const f32x4*)(c2 + 4);
                            if (t == 0) { u10 = *(const f32x4*)(cs + DFF); u11 = *(const f32x4*)(cs + DFF + 4); } } }
                    f32x4 cv0 = bc0 + wa0 * u20 + wb0 * u10 + wc0 * u00, cv1 = bc1 + wa1 * u21 + wb1 * u11 + wc1 * u01;
                    const f32x4 g0 = acc[ai][bj][m][0] + bg0, g1 = acc[ai][bj][m][1] + bg1;
#pragma unroll
                    for (int j = 0; j < 4; ++j) { cv0[j] = siluf_(cv0[j]) * g0[j]; cv1[j] = siluf_(cv1[j]) * g1[j]; }
                    u32x4 w; w.x = cvt_pk_bf16(cv0[0], cv0[1]); w.y = cvt_pk_bf16(cv0[2], cv0[3]); w.z = cvt_pk_bf16(cv1[0], cv1[1]); w.w = cvt_pk_bf16(cv1[2], cv1[3]);
                    *(u32x4*)(ACT + (size_t)row * DFF + col) = w;
                }
            }
        }
    }
};

struct EpiZ2 {
    static constexpr bool PERM = true;
    const bf16_t* X1B; const float* b_dn; float* out; float* part; int tailrow0;
    __device__ __forceinline__ void operator()(const Acc& acc, const Unit& u, int wr, int wc, int fr, int fq) const {
        const int col0 = u.pn * BM + wc * 32 + 8 * fq;
#pragma unroll
        for (int bj = 0; bj < 2; ++bj) {
            const int col = col0 + bj * HALF;
            const f32x4 b0 = *(const f32x4*)(b_dn + col), b1 = *(const f32x4*)(b_dn + col + 4);
#pragma unroll
            for (int ai = 0; ai < 2; ++ai) {
                u32x4 xr[4];
#pragma unroll
                for (int m = 0; m < 4; ++m) xr[m] = *(const u32x4*)(X1B + (size_t)(u.pm * BM + ai * HALF + wr * 64 + m * 16 + fr) * DM + col);
#pragma unroll
                for (int m = 0; m < 4; ++m) {
                    const int row = u.pm * BM + ai * HALF + wr * 64 + m * 16 + fr;
                    long yrow = -1;
                    if (row < RP) { const int b = row / TP, q = row - b * TP; if (q >= NMETA) yrow = (long)b * SEQ + (q - NMETA); }
                    else if (row < MR) yrow = (long)NB * SEQ + (row - RP);
                    if (yrow >= 0 || u.split) {
                        f32x4 v0 = acc[ai][bj][m][0], v1 = acc[ai][bj][m][1];
                        if (u.split <= 1) { f32x4 x0, x1; unpack8(xr[m], x0, x1); v0 = v0 + b0 + x0 * ALPHA; v1 = v1 + b1 + x1 * ALPHA; }
                        float* o = (u.split ? part + (size_t)(u.split - 1) * PART_STRIDE + (size_t)(row - tailrow0) * DM : out + (size_t)yrow * DM) + col;
                        *(f32x4*)o = v0; *(f32x4*)(o + 4) = v1;
                    }
                }
            }
        }
    }
};
}

constexpr int LQ = 0, LK = 17408, LV = 34816, LC = 52224, LSW = 87040, LA = 96256, LVEC = 129024;
constexpr int RSTR = 272, SWSTR = 144;
constexpr int V_BM = 0, V_AV = 64, V_DEC = 128, V_EM = 192, V_DENQ = 256, V_DENI = 320, V_SSQ = 384, V_WT = 448, V_NIN = 512, V_PSUM = 640, V_MISC = 1152;
constexpr int LG = LVEC + (V_MISC + 16) * 4;
constexpr int LGN = LG + 64 * RSTR;
static_assert(LG % 16 == 0 && LGN % 16 == 0 && LGN + 4096 <= LDS_BYTES - 16, "mixer LDS map");

__device__ __forceinline__ bf16x8 rowfrag(LAS unsigned char* base, int stride, int row0, int k0, int lane) {
    return *(const LAS bf16x8*)(base + (row0 + (lane & 15)) * stride + (k0 + 8 * (lane >> 4)) * 2);
}
__device__ __forceinline__ bf16x8 trfrag(LAS unsigned char* base, int stride, int k0, int c0, int lane) {
    const int g = lane >> 4, q = (lane & 15) >> 2, pp = lane & 3;
    LAS unsigned char* a = base + (k0 + 8 * g + q) * stride + (c0 + 4 * pp) * 2;
    const s16x4 lo = __builtin_amdgcn_ds_read_tr16_b64_v4i16((LAS s16x4*)a);
    const s16x4 hi = __builtin_amdgcn_ds_read_tr16_b64_v4i16((LAS s16x4*)(a + 4 * stride));
    return (bf16x8){lo[0], lo[1], lo[2], lo[3], hi[0], hi[1], hi[2], hi[3]};
}
__device__ __forceinline__ void load_chunk(LAS unsigned char* dst, const bf16_t* src, size_t ldg, int len, int tid) {
#pragma unroll
    for (int i = 0; i < 2; ++i) { const int q = tid + i * 512, s = q >> 4, cc = q & 15;
        u32x4 v = (u32x4){0u, 0u, 0u, 0u}; if (s < len) v = *(const u32x4*)(src + (size_t)s * ldg + cc * 8);
        *(LAS u32x4*)(dst + s * RSTR + cc * 16) = v; }
}
__device__ __forceinline__ void chunk_ld(u32x4 (&r)[2], const bf16_t* src, size_t ldg, int len, int tid) {
#pragma unroll
    for (int i = 0; i < 2; ++i) { const int q = tid + i * 512, s = q >> 4, cc = q & 15; r[i] = (u32x4){0u, 0u, 0u, 0u}; if (s < len) r[i] = *(const u32x4*)(src + (size_t)s * ldg + cc * 8); }
}
__device__ __forceinline__ void chunk_st(LAS unsigned char* dst, const u32x4 (&r)[2], int tid) {
#pragma unroll
    for (int i = 0; i < 2; ++i) { const int q = tid + i * 512, s = q >> 4, cc = q & 15; *(LAS u32x4*)(dst + s * RSTR + cc * 16) = r[i]; }
}
__device__ __forceinline__ void fb_ld(f32x4 (&fbv)[4], const float* FBsrc, int len, int tid) {
    const int c4 = tid & 31, sr = tid >> 5;
#pragma unroll
    for (int j = 0; j < 4; ++j) { const int s = sr + 16 * j; fbv[j] = (f32x4){0.f, 0.f, 0.f, 0.f}; if (s < len) fbv[j] = *(const f32x4*)(FBsrc + (size_t)s * 512 + c4 * 4); }
}
__device__ __forceinline__ void hgrn_prep(LAS unsigned char* lds, const f32x4 (&fbv)[4], const float* lbl, int h, int len, int tid) {
    LAS float* A = (LAS float*)(lds + LA); LAS float* vec = (LAS float*)(lds + LVEC);
    const int cch = tid & 127, part = tid >> 7;
    { const int c4 = tid & 31, sr = tid >> 5;
      const f32x4 l0 = *(const f32x4*)(lbl + h * 128 + c4 * 4), l1 = *(const f32x4*)(lbl + 512 + h * 128 + c4 * 4);
      f32x4 lb4;
#pragma unroll
      for (int k = 0; k < 4; ++k) lb4[k] = frcp(1.0f + __expf(l1[k] - l0[k]));
#pragma unroll
      for (int j = 0; j < 4; ++j) { const int s = sr + 16 * j;
        f32x4 lf = (f32x4){0.f, 0.f, 0.f, 0.f}, kb = lf;
        if (s < len) {
#pragma unroll
            for (int k = 0; k < 4; ++k) { const float sg = frcp(1.0f + __expf(-fbv[j][k])); const float f = lb4[k] + (1.0f - lb4[k]) * sg; lf[k] = __logf(f); kb[k] = (1.0f - lb4[k]) * (1.0f - sg); } }
        *(LAS f32x4*)(A + s * 128 + c4 * 4) = lf;
        u32x2 w; w.x = pk2(kb[0], kb[1]); w.y = pk2(kb[2], kb[3]); *(LAS u32x2*)(lds + LK + s * RSTR + c4 * 8) = w; } }
    __syncthreads();
    float v[16]; float run = 0.f;
#pragma unroll
    for (int i = 0; i < 16; ++i) { run += A[(part * 16 + i) * 128 + cch]; v[i] = run; }
    vec[V_PSUM + part * 128 + cch] = run;
    __syncthreads();
    float off = 0.f;
#pragma unroll
    for (int pp = 0; pp < 3; ++pp) if (pp < part) off += vec[V_PSUM + pp * 128 + cch];
#pragma unroll
    for (int i = 0; i < 16; ++i) A[(part * 16 + i) * 128 + cch] = v[i] + off;
    __syncthreads();
}

__device__ __forceinline__ void transpose_item(const float* W, int ldw, int K, bf16_t* WT, int k0, int n0, int sn0, LAS float* scr, int lane) {
    float tv[32];
#pragma unroll
    for (int i = 0; i < 32; ++i) { const int kk = 2 * i + (lane >> 5); tv[i] = W[(size_t)(k0 + kk) * ldw + sn0 + (lane & 31)]; }
#pragma unroll
    for (int i = 0; i < 32; ++i) { const int kk = 2 * i + (lane >> 5); scr[kk * 33 + (lane & 31)] = tv[i]; }
    asm volatile("s_waitcnt lgkmcnt(0)" ::: "memory");
    const int c = lane & 7;
#pragma unroll
    for (int j = 0; j < 4; ++j) { const int n = (lane >> 3) + 8 * j; const LAS float* s = scr + (8 * c) * 33 + n;
        u32x4 o; o.x = pk2(s[0 * 33], s[1 * 33]); o.y = pk2(s[2 * 33], s[3 * 33]); o.z = pk2(s[4 * 33], s[5 * 33]); o.w = pk2(s[6 * 33], s[7 * 33]);
        *(u32x4*)(WT + (size_t)(n0 + n) * K + k0 + 8 * c) = o; }
    asm volatile("s_waitcnt lgkmcnt(0)" ::: "memory");
}
#define XB_TMO      128
#define XB_XCNT(j)  (256  + 64 * (j))
#define XB_XSUB(j)  (1280 + 64 * (j))
#define XB_XGEN(j)  (2304 + 64 * (j))
#define XB_TOP      3328
#define XB_TOPGEN   3392
#define XCD_BAR_WORDS 3456
#define XB_SPIN_CAP (1u << 18)
__device__ __forceinline__ unsigned xb_ld(unsigned* p)              { return __hip_atomic_load(p, __ATOMIC_RELAXED, __HIP_MEMORY_SCOPE_AGENT); }
__device__ __forceinline__ unsigned xb_add(unsigned* p, unsigned v) { return __hip_atomic_fetch_add(p, v, __ATOMIC_RELAXED, __HIP_MEMORY_SCOPE_AGENT); }
__device__ __forceinline__ unsigned xb_xcc_id() { return (unsigned)__builtin_amdgcn_s_getreg((3 << 11) | 20) & 0xFu; }
#define XB_SPIN(cond, bar) do { unsigned _sp = 0; while (cond) { __builtin_amdgcn_s_sleep(1); \
    if ((++_sp & 255u) == 0u) { if (xb_ld(&(bar)[XB_TMO])) break; if (_sp > XB_SPIN_CAP) { atomicAdd(&(bar)[XB_TMO], 1u); break; } } } } while (0)
struct XcdBarrier { unsigned* bar; unsigned x; volatile LAS unsigned* st; };
__device__ __forceinline__ XcdBarrier xcd_barrier_post(unsigned* bar, volatile LAS unsigned* st) {
    XcdBarrier b; b.bar = bar; b.x = xb_xcc_id(); b.st = st;
    if (threadIdx.x == 0) (void)xb_add(&bar[XB_XCNT(b.x)], 1u);
    return b;
}
__device__ __forceinline__ void xcd_barrier_complete(unsigned* bar, unsigned x, unsigned& nloc, unsigned& nx) {
    const unsigned G = gridDim.x * gridDim.y * gridDim.z;
    unsigned sum, cnt, mine, sp = 0u;
    for (;;) {
        sum = 0u; cnt = 0u; mine = 0u;
#pragma unroll
        for (unsigned j = 0; j < 16; ++j) { const unsigned c = xb_ld(&bar[XB_XCNT(j)]); sum += c; cnt += (c > 0u) ? 1u : 0u; mine = (j == x) ? c : mine; }
        if (sum == G) break;
        __builtin_amdgcn_s_sleep(1);
        if ((++sp & 255u) == 0u) { if (xb_ld(&bar[XB_TMO])) break; if (sp > XB_SPIN_CAP) { atomicAdd(&bar[XB_TMO], 1u); break; } }
    }
    nloc = mine > 0u ? mine : 1u; nx = cnt > 0u ? cnt : 1u;
}
__device__ __forceinline__ void xcd_barrier(const XcdBarrier& b) {
    asm volatile("s_waitcnt vmcnt(0)" ::: "memory");
    __syncthreads();
    if (threadIdx.x == 0) {
        unsigned* bar = b.bar;
        __builtin_amdgcn_s_waitcnt(0);
        unsigned nloc = b.st[0], nx = b.st[1];
        if (nloc == 0u) { xcd_barrier_complete(bar, b.x, nloc, nx); b.st[0] = nloc; b.st[1] = nx; }
        const unsigned old = xb_add(&bar[XB_XSUB(b.x)], 1u);
        const unsigned gen = old / nloc;
        if (old + 1u == (gen + 1u) * nloc) {
            __builtin_amdgcn_fence(__ATOMIC_RELEASE, "agent");
            asm volatile("s_waitcnt vmcnt(0)" ::: "memory");
            const unsigned og = xb_add(&bar[XB_TOP], 1u);
            const unsigned tg = og / nx;
            if (og + 1u == (tg + 1u) * nx) xb_add(&bar[XB_TOPGEN], 1u);
            else XB_SPIN(xb_ld(&bar[XB_TOPGEN]) == tg, bar);
            __builtin_amdgcn_fence(__ATOMIC_ACQUIRE, "agent");
            xb_add(&bar[XB_XGEN(b.x)], 1u);
            asm volatile("s_waitcnt vmcnt(0)" ::: "memory");
        } else {
            XB_SPIN(xb_ld(&bar[XB_XGEN(b.x)]) == gen, bar);
            __builtin_amdgcn_fence(__ATOMIC_ACQUIRE, "agent");
            asm volatile("s_waitcnt vmcnt(0)" ::: "memory");
        }
    }
    __syncthreads();
}
#ifndef REP_P4
#define REP_P4 1
#endif
#ifndef REP_BAR
#define REP_BAR 1
#endif
#ifndef DBG_STOP
#define DBG_STOP -1
#endif
__device__ __forceinline__ void digest(float* out, const unsigned* w, size_t nwords, bool first, size_t gtid, size_t gthreads) {
    const size_t OUTN = 16777216;
    for (size_t i = gtid; i < OUTN; i += gthreads) { float a = first ? 0.f : out[i];
        for (size_t j = i; j < nwords; j += OUTN) { const unsigned x = w[j]; a += (float)(x & 0xffffu) * (1.f / 65536.f) + (float)(x >> 16) * (1.f / 65536.f); }
        out[i] = a; }
}
#define DG(off, bytes, first) digest(KOUT(), (const unsigned*)(KWS() + (off)), (size_t)(bytes) / 4, first, (size_t)bx * 512 + tid, (size_t)G * 512)
__global__ void __launch_bounds__(512, 2) fwd_kernel(Params p) {
    extern __shared__ __attribute__((aligned(16))) unsigned char lds_raw[];
    LAS unsigned char* lds = (LAS unsigned char*)lds_raw;
    const int tid = threadIdx.x, lane = tid & 63, wave = __builtin_amdgcn_readfirstlane(tid >> 6);
    const int G = gridDim.x, bx = blockIdx.x;
#define stats ((float*)(ws + WS_SMALL + SM_STATS))
#define IG ((float*)(ws + WS_SMALL + SM_IG))
#define LFA ((float*)(ws + WS_SMALL + SM_LFA))
#define CHKL ((float*)(ws + WS_SMALL + SM_CHKL))
#define CHKB ((float*)(ws + WS_SMALL + SM_CHKB))
#define MIN_ ((float*)(ws + WS_SMALL + SM_MIN))
#define CHKN ((float*)(ws + WS_SMALL + SM_CHKN))
#define NIN ((float*)(ws + WS_SMALL + SM_NIN))
#define CHKA ((float*)(ws + WS_SMALL + SM_CHKA))
    LAS float* vec = (LAS float*)(lds + LVEC);
    { volatile LAS unsigned* st0 = (volatile LAS unsigned*)(lds + LDS_BYTES - 16); if (tid < 4) st0[tid] = 0u; }
    __syncthreads();
    const XcdBarrier xbar = xcd_barrier_post((unsigned*)(KWS() + WS_SMALL + SM_BAR), (volatile LAS unsigned*)(lds + LDS_BYTES - 16));
#define GSYNC() xcd_barrier(xbar)

    {
        unsigned char* const ws = KWS();
        const int gw = bx * 8 + wave, NGW = G * 8;
        LAS float* scr = (LAS float*)(lds + wave * 8448);
        { const float* W = KIN(10); bf16_t* WT = (bf16_t*)(ws + WS_WIN);
          for (int it = gw; it < 16 * 128; it += NGW) { const int kb = it >> 7, nb = it & 127, n0 = 32 * nb; transpose_item(W, DIN, 1024, WT, 64 * kb, n0, n0 >= 2048 ? n0 + 8 : n0, scr, lane); } }
        __syncthreads();
        LAS float* wg = (LAS float*)(lds + 69632);
        { const float* win = KIN(10); float wv[16];
#pragma unroll
          for (int i = 0; i < 16; ++i) { const int idx = tid + i * 512; wv[i] = win[(size_t)(idx >> 3) * DIN + 2048 + (idx & 7)]; }
#pragma unroll
          for (int i = 0; i < 16; ++i) { const int idx = tid + i * 512; wg[(idx & 7) * 1024 + (idx >> 3)] = wv[i]; } }
        __syncthreads();
        bf16_t* XN = (bf16_t*)(ws + WS_XN);
        const float* lg = KIN(8); const float* lb = KIN(9);
        const float* xpr = KIN(0); const float* xsm = KIN(1); const float* meta = KIN(7);
        float bi_i = 0.f, bi_f = 0.f;
        if (lane < 4) { bi_i = KIN(11)[2048 + lane]; bi_f = KIN(11)[2052 + lane] + KIN(12)[lane]; }
        f32x4 nv[4];
        if (gw < MR) { const f32x4* x0 = (const f32x4*)xrow_ptr(xpr, xsm, meta, gw) + lane;
#pragma unroll
            for (int j = 0; j < 4; ++j) nv[j] = x0[64 * j]; }
        for (int r = gw; r < MP; r += NGW) {
            unsigned long long* o8 = (unsigned long long*)(XN + (size_t)r * DM) + lane;
            f32x4 v[4]; float s = 0.f;
#pragma unroll
            for (int j = 0; j < 4; ++j) v[j] = nv[j];
            if (r + NGW < MR) { const f32x4* xn = (const f32x4*)xrow_ptr(xpr, xsm, meta, r + NGW) + lane;
#pragma unroll
                for (int j = 0; j < 4; ++j) nv[j] = xn[64 * j]; }
            if (r >= MR) {
#pragma unroll
                for (int j = 0; j < 4; ++j) o8[64 * j] = 0ull;
                continue; }
#pragma unroll
            for (int j = 0; j < 4; ++j) s += (v[j].x + v[j].y) + (v[j].z + v[j].w);
            const float mean = wave_sum(s) * (1.f / DM); float s2 = 0.f;
#pragma unroll
            for (int j = 0; j < 4; ++j) { v[j] = v[j] - mean; s2 += (v[j].x * v[j].x + v[j].y * v[j].y) + (v[j].z * v[j].z + v[j].w * v[j].w); }
            const float rstd = 1.f / sqrtf(wave_sum(s2) * (1.f / DM) + LN_EPS);
            float gd[8];
#pragma unroll
            for (int g = 0; g < 8; ++g) gd[g] = 0.f;
#pragma unroll
            for (int j = 0; j < 4; ++j) {
                const f32x4 gg = *((const f32x4*)lg + lane + 64 * j), bb = *((const f32x4*)lb + lane + 64 * j);
                v[j] = v[j] * rstd * gg + bb;
                o8[64 * j] = (unsigned long long)pk2(v[j].x, v[j].y) | ((unsigned long long)pk2(v[j].z, v[j].w) << 32);
#pragma unroll
                for (int g = 0; g < 8; ++g) { const f32x4 w = *((const LAS f32x4*)(wg + g * 1024) + lane + 64 * j); gd[g] += (v[j].x * w.x + v[j].y * w.y) + (v[j].z * w.z + v[j].w * w.w); }
            }
#pragma unroll
            for (int g = 0; g < 8; ++g) gd[g] = wave_sum(gd[g]);
            if (lane == 0) { stats[2 * r] = mean; stats[2 * r + 1] = rstd; }
            if (lane < 4) {
                float gi = gd[0], gf = gd[4];
                if (lane == 1) { gi = gd[1]; gf = gd[5]; } else if (lane == 2) { gi = gd[2]; gf = gd[6]; } else if (lane == 3) { gi = gd[3]; gf = gd[7]; }
                IG[r * 4 + lane] = gi + bi_i;
                const float x = gf + bi_f;
                LFA[r * 4 + lane] = (x < 0.f) ? x - log1pf(expf(x)) : -log1pf(expf(-x));
            }
        }
    }
    GSYNC();
    if (DBG_STOP == 0) { DG(0, 26 * MiB + 512 * 1024, true); DG(WS_XN, SZ_R1024, false); DG(WS_SMALL + SM_STATS, (size_t)MR * 8, false); DG(WS_SMALL + SM_IG, (size_t)MR * 16, false); DG(WS_SMALL + SM_LFA, (size_t)MR * 16, false); return; }

    {
        unsigned char* const ws = KWS();
        pg8::Gemm g{(const bf16_t*)(ws + WS_XN), (const bf16_t*)(ws + WS_WIN), MP, 4096, 1024}; pg8::StaticOrder S; S.init(MP, 4096, G, bx);
        pg8::EpiIn E{ws, KIN(11)};
        pg8::gemm_phase<pg8::EpiIn, pg8::StaticOrder, true, true>(lds, g, S, E);
        {
            const int nwg = (MP / 256) * 16, rem = nwg % G, nfree = rem ? G - rem : G, fb = rem ? bx - rem : bx;
            if (fb >= 0) {
                LAS float* scr = (LAS float*)(lds + wave * 8448);
                constexpr int I_OUT = 16 * 32, I_UP = 16 * 176, I_DN = 44 * 32;
                for (int it = fb * 8 + wave; it < I_OUT + I_UP + I_DN; it += nfree * 8) {
                    int r = it;
                    if (r < I_OUT) { transpose_item(KIN(16), 1024, 1024, (bf16_t*)(ws + WS_WOUT), 64 * (r / 32), 32 * (r % 32), 32 * (r % 32), scr, lane); continue; } r -= I_OUT;
                    if (r < I_UP) { transpose_item(KIN(20), 2 * DFF, 1024, (bf16_t*)(ws + WS_WUP), 64 * (r / 176), 32 * (r % 176), 32 * (r % 176), scr, lane); continue; } r -= I_UP;
                    transpose_item(KIN(24), 1024, DFF, (bf16_t*)(ws + WS_WDN), 64 * (r / 32), 32 * (r % 32), 32 * (r % 32), scr, lane);
                }
            }
        }
    }
    GSYNC();
    if (DBG_STOP == 1) { DG(WS_QAB, SZ_R1024 + 5 * SZ_R512 + SZ_R1024, true); return; }

    { unsigned char* const ws = KWS(); const float* lbl = KIN(15);
    for (int item = bx; item < 2 * NSLOT; item += G) {
        const int type = item / NSLOT, j = item - type * NSLOT, b = j / 132, rem = j - b * 132, h = rem / NCH, c = rem - h * NCH;
        const int p0 = c ? NMETA + (c - 1) * 64 : 0, len = c ? 64 : NMETA, r0 = b * TP + p0;
        u32x4 rk[2], rv[2]; f32x4 fbv[4];
        chunk_ld(rv, (const bf16_t*)(ws + (type ? WS_IB : WS_VA)) + (size_t)r0 * 512 + h * 128, 512, len, tid);
        if (type == 0) chunk_ld(rk, (const bf16_t*)(ws + WS_KA) + (size_t)r0 * 512 + h * 128, 512, len, tid);
        else fb_ld(fbv, (const float*)(ws + WS_FB) + (size_t)r0 * 512 + h * 128, len, tid);
        __syncthreads();
        chunk_st(lds + LV, rv, tid);
        if (type == 0) {
            if (wave == 0) {
                const bool valid = lane < len;
                const float ig = valid ? IG[(r0 + lane) * 4 + h] : 0.f; float bc = valid ? LFA[(r0 + lane) * 4 + h] : 0.f;
#pragma unroll
                for (int o = 1; o < 64; o <<= 1) { const float t = __shfl_up(bc, o); if (lane >= o) bc += t; }
                const float a = valid ? ig - bc : -INFINITY; float mx = a;
#pragma unroll
                for (int o = 1; o < 64; o <<= 1) mx = fmaxf(mx, __shfl_xor(mx, o));
                const float bT = __shfl(bc, len - 1);
                vec[V_WT + lane] = valid ? __expf(a - mx) : 0.f;
                if (lane == 0) { CHKL[j] = mx; CHKB[j] = bT; }
            }
            __syncthreads();
#pragma unroll
            for (int i = 0; i < 2; ++i) { const int q = tid + i * 512, s = q >> 4, cc = q & 15;
                u32x4 v = rk[i];
                if (s < len) { const float w = vec[V_WT + s];
                    v.x = pk2(bflo(v.x) * w, bfhi(v.x) * w); v.y = pk2(bflo(v.y) * w, bfhi(v.y) * w); v.z = pk2(bflo(v.z) * w, bfhi(v.z) * w); v.w = pk2(bflo(v.w) * w, bfhi(v.w) * w); }
                *(LAS u32x4*)(lds + LK + s * RSTR + cc * 16) = v; }
            __syncthreads();
            if (tid < 128) { float s = 0.f;
#pragma unroll 8
                for (int q = 0; q < 64; ++q) s += bf2f(*(const LAS bf16_t*)(lds + LK + q * RSTR + tid * 2));
                CHKN[j * 128 + tid] = s; }
        } else {
            hgrn_prep(lds, fbv, lbl, h, len, tid);
            LAS float* A = (LAS float*)(lds + LA);
            const int cch = tid & 127, part = tid >> 7;
            const float aT = A[(len - 1) * 128 + cch];
            if (tid < 128) CHKA[j * 128 + tid] = aT;
#pragma unroll 4
            for (int i = 0; i < 16; ++i) { const int s = part + 4 * i; LAS bf16_t* kp = (LAS bf16_t*)(lds + LK + s * RSTR + cch * 2);
                *kp = (bf16_t)f2bf(__expf(aT - A[s * 128 + cch]) * bf2f(*kp)); }
            __syncthreads();
        }
        {
            bf16_t* dst = (bf16_t*)(ws + (type ? WS_CSTH : WS_CSTM)) + (size_t)j * 16384;
            const int e0 = 16 * wave;
            const bf16x8 a0 = trfrag(lds + LV, RSTR, 0, e0, lane), a1 = trfrag(lds + LV, RSTR, 32, e0, lane);
#pragma unroll 2
            for (int dt = 0; dt < 8; ++dt) {
                f32x4 acc = (f32x4){0.f, 0.f, 0.f, 0.f};
                const bf16x8 b0 = trfrag(lds + LK, RSTR, 0, 16 * dt, lane), b1 = trfrag(lds + LK, RSTR, 32, 16 * dt, lane);
                acc = __builtin_amdgcn_mfma_f32_16x16x32_bf16(a0, b0, acc, 0, 0, 0);
                acc = __builtin_amdgcn_mfma_f32_16x16x32_bf16(a1, b1, acc, 0, 0, 0);
                u32x2 w; w.x = pk2(acc[0], acc[1]); w.y = pk2(acc[2], acc[3]);
                *(u32x2*)(dst + (16 * dt + (lane & 15)) * 128 + e0 + 4 * (lane >> 4)) = w;
            }
        }
    } }
    GSYNC();
    if (DBG_STOP == 2) { DG(WS_CSTM, SZ_CST, true); DG(WS_CSTH, SZ_CST, false); DG(WS_SMALL + SM_CHKL, NSLOT * 4, false); DG(WS_SMALL + SM_CHKB, NSLOT * 4, false); DG(WS_SMALL + SM_CHKN, NSLOT * 512, false); DG(WS_SMALL + SM_CHKA, NSLOT * 512, false); return; }

    { unsigned char* const ws = KWS(); float* const outp = KOUT();
    for (int unit = bx; unit < 2 * NB * 4 * 4; unit += G) {
        const int type = unit >> 7, sq = (unit >> 2) & 31, quarter = unit & 3;
        const int eo = quarter * 4096 + tid * 8, d = eo >> 7;
        bf16_t* base = (bf16_t*)(ws + (type ? WS_CSTH : WS_CSTM)) + (size_t)sq * NCH * 16384 + eo;
        const bool nthr = (type == 0 && quarter == 0 && tid < 128);
        __syncthreads();
        if (type == 0 && tid < NCH) { vec[tid] = CHKL[sq * NCH + tid]; vec[64 + tid] = CHKB[sq * NCH + tid]; }
        __syncthreads();
        float carry[8];
#pragma unroll
        for (int i = 0; i < 8; ++i) carry[i] = 0.f;
        float m_in = 0.f, ncar = 0.f;
#pragma unroll 1
        for (int cg = 0; cg < NCH; cg += 11) {
            u32x4 uu[11]; float aux[11];
#pragma unroll
            for (int k = 0; k < 11; ++k) uu[k] = *(const u32x4*)(base + (size_t)(cg + k) * 16384);
#pragma unroll
            for (int k = 0; k < 11; ++k) aux[k] = (type == 0) ? (nthr ? CHKN[(sq * NCH + cg + k) * 128 + tid] : 0.f) : CHKA[(sq * NCH + cg + k) * 128 + d];
#pragma unroll
            for (int k = 0; k < 11; ++k) {
                const int c = cg + k, sidx = sq * NCH + c;
                u32x4 w; w.x = pk2(carry[0], carry[1]); w.y = pk2(carry[2], carry[3]); w.z = pk2(carry[4], carry[5]); w.w = pk2(carry[6], carry[7]);
                *(u32x4*)(base + (size_t)c * 16384) = w;
                float al, be;
                if (type == 0) {
                    const float L = vec[c], bT = vec[64 + c]; const float mn = bT + fmaxf(m_in, L);
                    al = __expf(bT + m_in - mn); be = __expf(bT + L - mn);
                    if (quarter == 0 && tid == 0) MIN_[sidx] = m_in;
                    if (nthr) { NIN[sidx * 128 + tid] = ncar; ncar = al * ncar + be * aux[k]; }
                    m_in = mn;
                } else { al = __expf(aux[k]); be = 1.f; }
                const u32x4 u4 = uu[k];
                carry[0] = al * carry[0] + be * bflo(u4.x); carry[1] = al * carry[1] + be * bfhi(u4.x);
                carry[2] = al * carry[2] + be * bflo(u4.y); carry[3] = al * carry[3] + be * bfhi(u4.y);
                carry[4] = al * carry[4] + be * bflo(u4.z); carry[5] = al * carry[5] + be * bfhi(u4.z);
                carry[6] = al * carry[6] + be * bflo(u4.w); carry[7] = al * carry[7] + be * bfhi(u4.w);
            }
        }
        float* o = outp + (type ? O_SP : O_CP) + (size_t)sq * 16384 + eo;
        *(f32x4*)o = (f32x4){carry[0], carry[1], carry[2], carry[3]}; *(f32x4*)(o + 4) = (f32x4){carry[4], carry[5], carry[6], carry[7]};
        if (nthr) outp[O_NP + sq * 128 + tid] = ncar;
        if (type == 0 && quarter == 0 && tid == 0) outp[O_MPR + sq] = m_in;
    } }
    GSYNC();
    if (DBG_STOP == 3) { DG(WS_CSTM, SZ_CST, true); DG(WS_CSTH, SZ_CST, false); DG(WS_SMALL + SM_MIN, NSLOT * 4, false); DG(WS_SMALL + SM_NIN, NSLOT * 512, false); return; }

    { unsigned char* const ws = KWS(); float* const outp = KOUT(); const float* lbl = KIN(15);
      const float* stC = KIN(2); const float* stN = KIN(3); const float* stM = KIN(4); const float* stS = KIN(5); const float* gna = KIN(13); const float* gnb = KIN(14);
#define P4_DECODE(it_) do { const int it__ = (it_); n_sidx = 0; n_sb = 0; n_sample = false; \
        if (it__ < 2 * NSLOT) { n_type = it__ / NSLOT; const int j = it__ - n_type * NSLOT, b = j / 132, rem = j - b * 132; n_h = rem / NCH; const int c = rem - n_h * NCH; \
            n_len = c ? 64 : NMETA; n_r0 = b * TP + (c ? NMETA + (c - 1) * 64 : 0); n_sidx = j; } \
        else { const int j = it__ - 2 * NSLOT; n_type = j >> 9; const int rem = j & 511; n_sb = rem >> 2; n_h = rem & 3; n_len = DS; n_r0 = RP + n_sb * DS; n_sample = true; } } while (0)
#define P4_ISSUE() do { \
        chunk_ld(rq, (const bf16_t*)(ws + WS_QAB) + (size_t)n_r0 * 1024 + n_type * 512 + n_h * 128, 1024, n_len, tid); \
        chunk_ld(rv, (const bf16_t*)(ws + (n_type ? WS_IB : WS_VA)) + (size_t)n_r0 * 512 + n_h * 128, 512, n_len, tid); \
        if (n_type == 0) { u32x4 rk_[2]; chunk_ld(rk_, (const bf16_t*)(ws + WS_KA) + (size_t)n_r0 * 512 + n_h * 128, 512, n_len, tid); fbv[0] = __builtin_bit_cast(f32x4, rk_[0]); fbv[1] = __builtin_bit_cast(f32x4, rk_[1]); } \
        else fb_ld(fbv, (const float*)(ws + WS_FB) + (size_t)n_r0 * 512 + n_h * 128, n_len, tid); \
        if (!n_sample) { const bf16_t* cs = (const bf16_t*)(ws + (n_type ? WS_CSTH : WS_CSTM)) + (size_t)n_sidx * 16384; \
            _Pragma("unroll") for (int i = 0; i < 4; ++i) { const int q = tid + i * 512, d = q >> 4, cc = q & 15; cst[i] = *(const f32x4*)(cs + d * 128 + cc * 8); } } \
        if (n_type == 0) { \
            if (wave == 0) { const bool valid_ = lane < n_len; pg_a = valid_ ? IG[(n_r0 + lane) * 4 + n_h] : 0.f; pg_b = valid_ ? LFA[(n_r0 + lane) * 4 + n_h] : 0.f; \
                pg_m = n_sample ? stM[n_sb * 4 + n_h] : MIN_[n_sidx]; } \
            else if (wave == 2 || wave == 3) { const int d_ = tid - 128; pg_a = n_sample ? stN[(n_sb * 4 + n_h) * 128 + d_] : NIN[n_sidx * 128 + d_]; } } \
        } while (0)
    u32x4 rq[2], rv[2]; f32x4 cst[4]; f32x4 fbv[4];
    float pg_a = 0.f, pg_b = 0.f, pg_m = 0.f;
    __syncthreads();
    { LAS float* gl = (LAS float*)(lds + LGN); gl[tid] = gna[tid]; gl[512 + tid] = gnb[tid]; }
    int n_type = 0, n_h = 0, n_len = 0, n_r0 = 0, n_sidx = 0, n_sb = 0; bool n_sample = false;
    constexpr int P4N = 2 * NSLOT + 1024;
    if (bx < P4N) { P4_DECODE(bx); P4_ISSUE(); }
    for (int item = bx; item < P4N; item += G) {
        const int type = n_type, h = n_h, len = n_len, r0 = n_r0, sidx = n_sidx, sb = n_sb; const bool sample = n_sample;
        const float* Csrc = (type ? stS : stC) + (size_t)(sb * 4 + h) * 16384;
        __syncthreads();
        u32x4 rg[2]; chunk_ld(rg, (const bf16_t*)(ws + (type ? WS_GB : WS_OA)) + (size_t)r0 * 512 + h * 128, 512, len, tid);
        chunk_st(lds + LQ, rq, tid); chunk_st(lds + LV, rv, tid);
        if (type == 0) { u32x4 rk_[2]; rk_[0] = __builtin_bit_cast(u32x4, fbv[0]); rk_[1] = __builtin_bit_cast(u32x4, fbv[1]); chunk_st(lds + LK, rk_, tid); }
        if (!sample) {
#pragma unroll
            for (int i = 0; i < 4; ++i) { const int q = tid + i * 512, d = q >> 4, cc = q & 15; *(LAS f32x4*)(lds + LC + d * RSTR + cc * 16) = cst[i]; }
        } else {
            f32x4 sst[8];
#pragma unroll
            for (int i = 0; i < 8; ++i) { const int q = tid + i * 512, d = q >> 5, c4 = q & 31; sst[i] = *(const f32x4*)(Csrc + d * 128 + c4 * 4); }
#pragma unroll
            for (int i = 0; i < 8; ++i) { const int q = tid + i * 512, d = q >> 5, c4 = q & 31; const f32x4 v = sst[i];
                u32x2 w; w.x = pk2(v.x, v.y); w.y = pk2(v.z, v.w); *(LAS u32x2*)(lds + LC + d * RSTR + c4 * 8) = w; }
        }
        if (tid < 64) { vec[V_DENI + tid] = 0.f; vec[V_SSQ + tid] = 0.f; }
        if (type == 0) {
            if (wave == 0) {
                const bool valid = lane < len;
                const float m_in = pg_m;
                const float ig = pg_a; float bc = pg_b;
#pragma unroll
                for (int o = 1; o < 64; o <<= 1) { const float t = __shfl_up(bc, o); if (lane >= o) bc += t; }
                const float a = valid ? ig - bc : -INFINITY; float mx = a;
#pragma unroll
                for (int o = 1; o < 64; o <<= 1) { const float t = __shfl_up(mx, o); if (lane >= o) mx = fmaxf(mx, t); }
                const float mt = bc + fmaxf(m_in, mx);
                vec[V_BM + lane] = bc - mt; vec[V_AV + lane] = a; vec[V_DEC + lane] = __expf(bc + m_in - mt); vec[V_EM + lane] = __expf(-mt);
                const float bmT = __shfl(bc - mt, len - 1);
                vec[V_WT + lane] = valid ? __expf(bmT + a) : 0.f;
                if (sample && lane == len - 1) outp[O_MS + sb * 4 + h] = mt;
            } else if (wave == 2 || wave == 3) {
                const int d = tid - 128;
                vec[V_NIN + d] = pg_a;
            }
            __syncthreads();
        } else {
            hgrn_prep(lds, fbv, lbl, h, len, tid);
            LAS float* A = (LAS float*)(lds + LA);
            const int cch = tid & 127, part = tid >> 7;
#pragma unroll 4
            for (int i = 0; i < 16; ++i) { const int s = part + 4 * i; const float a = A[s * 128 + cch];
                LAS bf16_t* kp = (LAS bf16_t*)(lds + LK + s * RSTR + cch * 2); *kp = (bf16_t)f2bf(__expf(-a) * bf2f(*kp));
                LAS bf16_t* qp = (LAS bf16_t*)(lds + LQ + s * RSTR + cch * 2); *qp = (bf16_t)f2bf(__expf(a) * bf2f(*qp)); }
            __syncthreads();
        }
        if (type == 0) {
            const int t = tid >> 3, part = tid & 7; float s = 0.f;
            const LAS bf16_t* qp = (const LAS bf16_t*)(lds + LQ + t * RSTR) + part * 16;
#pragma unroll
            for (int i = 0; i < 16; ++i) s += bf2f(qp[i]) * vec[V_NIN + part * 16 + i];
            s += __shfl_xor(s, 1); s += __shfl_xor(s, 2); s += __shfl_xor(s, 4);
            if (part == 0) vec[V_DENQ + t] = s * vec[V_DEC + t];
        }
        chunk_st(lds + LG, rg, tid);
        {
            const int t0 = 16 * (wave & 3), tt = t0 + (lane & 15);
            bf16x8 qf[4];
#pragma unroll
            for (int k = 0; k < 4; ++k) qf[k] = rowfrag(lds + LQ, RSTR, t0, 32 * k, lane);
            const float bmt = (type == 0) ? vec[V_BM + tt] : 0.f;
            float rsum = 0.f;
#pragma unroll
            for (int si = 0; si < 2; ++si) {
                const int s0 = 16 * ((wave >> 2) * 2 + si);
                f32x4 acc = (f32x4){0.f, 0.f, 0.f, 0.f};
#pragma unroll
                for (int k = 0; k < 4; ++k) acc = __builtin_amdgcn_mfma_f32_16x16x32_bf16(rowfrag(lds + LK, RSTR, s0, 32 * k, lane), qf[k], acc, 0, 0, 0);
                float sw[4];
#pragma unroll
                for (int jj = 0; jj < 4; ++jj) { const int s = s0 + 4 * (lane >> 4) + jj; const bool ok = (s <= tt) && (s < len);
                    float w = 1.f; if (type == 0) w = __expf(bmt + (ok ? vec[V_AV + s] : 0.f));
                    sw[jj] = ok ? acc[jj] * w : 0.f; rsum += sw[jj]; }
                u32x2 w2; w2.x = pk2(sw[0], sw[1]); w2.y = pk2(sw[2], sw[3]);
                *(LAS u32x2*)(lds + LSW + tt * SWSTR + (s0 + 4 * (lane >> 4)) * 2) = w2;
            }
            if (type == 0) { rsum += __shfl_xor(rsum, 16); rsum += __shfl_xor(rsum, 32); if (lane < 16) atomicAdd((float*)(vec + V_DENI + tt), rsum); }
        }
        __syncthreads();
        { const int nxi = item + G; if (nxi < P4N) { P4_DECODE(nxi); P4_ISSUE(); } }
        {
            const int t0 = 16 * (wave & 3), tt = t0 + (lane & 15);
            bf16x8 qf[4], sf[2];
#pragma unroll
            for (int k = 0; k < 4; ++k) qf[k] = rowfrag(lds + LQ, RSTR, t0, 32 * k, lane);
#pragma unroll
            for (int k = 0; k < 2; ++k) sf[k] = rowfrag(lds + LSW, SWSTR, t0, 32 * k, lane);
            float dect = 1.f, rden = 1.f;
            if (type == 0) { dect = vec[V_DEC + tt]; const float den = vec[V_DENQ + tt] + vec[V_DENI + tt]; rden = frcp(fmaxf(fabsf(den), vec[V_EM + tt])); }
            f32x4 hv[4]; float ss = 0.f;
#pragma unroll
            for (int ei = 0; ei < 4; ++ei) {
                const int e0 = 16 * ((wave >> 2) * 4 + ei);
                f32x4 a1 = (f32x4){0.f, 0.f, 0.f, 0.f}, a2 = a1;
#pragma unroll
                for (int k = 0; k < 4; ++k) a1 = __builtin_amdgcn_mfma_f32_16x16x32_bf16(trfrag(lds + LC, RSTR, 32 * k, e0, lane), qf[k], a1, 0, 0, 0);
#pragma unroll
                for (int k = 0; k < 2; ++k) a2 = __builtin_amdgcn_mfma_f32_16x16x32_bf16(trfrag(lds + LV, RSTR, 32 * k, e0, lane), sf[k], a2, 0, 0, 0);
                hv[ei] = (a1 * dect + a2) * rden;
                ss += (hv[ei][0] * hv[ei][0] + hv[ei][1] * hv[ei][1]) + (hv[ei][2] * hv[ei][2] + hv[ei][3] * hv[ei][3]);
            }
            ss += __shfl_xor(ss, 16); ss += __shfl_xor(ss, 32);
            if (lane < 16) atomicAdd((float*)(vec + V_SSQ + tt), ss);
            __syncthreads();
            const float rs = rsqrtf(vec[V_SSQ + tt] * (1.0f / 128.0f) + RMS_EPS);
            if (tt < len) {
                const LAS float* gn = (const LAS float*)(lds + LGN) + type * 512 + h * 128;
                bf16_t* dst = (bf16_t*)(ws + WS_QAB) + (size_t)(r0 + tt) * 1024 + type * 512 + h * 128;
#pragma unroll
                for (int ei = 0; ei < 4; ++ei) {
                    const int e = 16 * ((wave >> 2) * 4 + ei) + 4 * (lane >> 4);
                    const u32x2 gt = *(const LAS u32x2*)(lds + LG + tt * RSTR + e * 2); const f32x4 g4 = *(const LAS f32x4*)(gn + e);
                    const f32x4 o = hv[ei] * rs * g4 * (f32x4){bflo(gt.x), bfhi(gt.x), bflo(gt.y), bfhi(gt.y)};
                    u32x2 w; w.x = pk2(o[0], o[1]); w.y = pk2(o[2], o[3]); *(u32x2*)(dst + e) = w;
                }
            }
        }
        if (sample) {
            const int e4 = tid & 31, dg = tid >> 5;
            LAS float* A = (LAS float*)(lds + LA);
            f32x4 vv[DS];
#pragma unroll
            for (int s = 0; s < DS; ++s) { const u32x2 t = *(const LAS u32x2*)(lds + LV + s * RSTR + e4 * 8); const float w = (type == 0) ? vec[V_WT + s] : 1.f;
                vv[s] = (f32x4){bflo(t.x), bfhi(t.x), bflo(t.y), bfhi(t.y)} * w; }
            const float decT = (type == 0) ? vec[V_DEC + DS - 1] : 1.f;
            float* od = outp + (type ? O_SS : O_CS) + (size_t)(sb * 4 + h) * 16384;
#pragma unroll 2
            for (int i = 0; i < 8; ++i) { const int d = dg + 16 * i;
                const float rsc = (type == 0) ? decT : __expf(A[(DS - 1) * 128 + d]); const float ksc = (type == 0) ? 1.f : rsc;
                f32x4 o = *(const f32x4*)(Csrc + d * 128 + e4 * 4) * rsc;
#pragma unroll
                for (int s = 0; s < DS; ++s) o += vv[s] * (ksc * bf2f(*(const LAS bf16_t*)(lds + LK + s * RSTR + d * 2)));
                *(f32x4*)(od + d * 128 + e4 * 4) = o; }
            if (type == 0 && tid < 128) { float n = decT * vec[V_NIN + tid];
#pragma unroll
                for (int s = 0; s < DS; ++s) n += vec[V_WT + s] * bf2f(*(const LAS bf16_t*)(lds + LK + s * RSTR + tid * 2));
                outp[O_NS + (sb * 4 + h) * 128 + tid] = n; }
        }
    } }
    GSYNC();
    if (DBG_STOP == 4) { DG(WS_QAB, SZ_R1024, true); return; }

    {
        unsigned char* const ws = KWS();
        pg8::Gemm g{(const bf16_t*)(ws + WS_QAB), (const bf16_t*)(ws + WS_WOUT), MP, 1024, 1024}; pg8::TailSplitOrder S; S.init(MP, 1024, G, bx, 1024, 8);
        pg8::EpiZ1 E{KIN(0), KIN(1), KIN(7), KIN(8), KIN(9), KIN(17), stats, (float*)(ws + WS_Z1), KOUT(), S.tail_row0()};
        pg8::gemm_phase<pg8::EpiZ1, pg8::TailSplitOrder, true, true>(lds, g, S, E);
    }
    GSYNC();
    if (DBG_STOP == 5) { DG(WS_Z1, 2 * SZ_R1024, true); return; }
    {
        unsigned char* const ws = KWS();
        const int gw = bx * 8 + wave, NGW = G * 8;
        const float* z1 = (const float*)(ws + WS_Z1); bf16_t* X1B = (bf16_t*)(ws + WS_X1B);
        pg8::TailSplitOrder S5; S5.init(MP, 1024, G, bx, 1024, 8); const int tr0 = S5.tail_row0(); const float* ztail = KOUT();
        const float* lg = KIN(18); const float* lb = KIN(19);
#define Z1ROW(r_) ((const f32x4*)((r_) >= tr0 ? ztail + (size_t)((r_) - tr0) * DM : z1 + (size_t)(r_) * DM) + lane)
        f32x4 nv[4];
        if (gw < MR) { const f32x4* xr = Z1ROW(gw);
#pragma unroll
            for (int j = 0; j < 4; ++j) nv[j] = xr[64 * j]; }
        for (int r = gw; r < MP; r += NGW) {
            unsigned long long* o8 = (unsigned long long*)(X1B + (size_t)r * DM) + lane;
            f32x4 v[4]; float s = 0.f;
#pragma unroll
            for (int j = 0; j < 4; ++j) v[j] = nv[j];
            if (r + NGW < MR) { const f32x4* xn = Z1ROW(r + NGW);
#pragma unroll
                for (int j = 0; j < 4; ++j) nv[j] = xn[64 * j]; }
            if (r >= MR) {
#pragma unroll
                for (int j = 0; j < 4; ++j) o8[64 * j] = 0ull;
                continue; }
            const f32x4* xr = Z1ROW(r);
            if (r >= tr0) for (int pc = 1; pc < 8; ++pc) {
#pragma unroll
                for (int j = 0; j < 4; ++j) v[j] += xr[pc * (pg8::PART_STRIDE / 4) + 64 * j]; }
#pragma unroll
            for (int j = 0; j < 4; ++j) s += (v[j].x + v[j].y) + (v[j].z + v[j].w);
            const float mean = wave_sum(s) * (1.f / DM); float s2 = 0.f;
#pragma unroll
            for (int j = 0; j < 4; ++j) { v[j] = v[j] - mean; s2 += (v[j].x * v[j].x + v[j].y * v[j].y) + (v[j].z * v[j].z + v[j].w * v[j].w); }
            const float rstd = 1.f / sqrtf(wave_sum(s2) * (1.f / DM) + LN_EPS);
#pragma unroll
            for (int j = 0; j < 4; ++j) {
                const f32x4 gg = *((const f32x4*)lg + lane + 64 * j), bb = *((const f32x4*)lb + lane + 64 * j);
                v[j] = v[j] * rstd * gg + bb;
                o8[64 * j] = (unsigned long long)pk2(v[j].x, v[j].y) | ((unsigned long long)pk2(v[j].z, v[j].w) << 32);
            }
        }
    }
    GSYNC();
    if (DBG_STOP == 6) { DG(WS_X1B, SZ_R1024, true); return; }
    {
        unsigned char* const ws = KWS();
        pg8::Gemm g{(const bf16_t*)(ws + WS_X1B), (const bf16_t*)(ws + WS_WUP), MP, DFF, 1024}; pg8::StaticOrder S; S.init(MP, DFF, G, bx);
        pg8::EpiU E{(bf16_t*)(ws + WS_U), KIN(21), KOUT()};
        pg8::gemm_phase<pg8::EpiU, pg8::StaticOrder, true, true>(lds, g, S, E);
    }
    GSYNC();
    if (DBG_STOP == 7) { DG(WS_U, SZ_U, true); return; }
    {
        unsigned char* const ws = KWS();
        pg8::Gemm g{(const bf16_t*)(ws + WS_X1B), (const bf16_t*)(ws + WS_WUP) + (size_t)DFF * 1024, MP, DFF, 1024}; pg8::StaticOrder S; S.init(MP, DFF, G, bx);
        pg8::EpiAct E{(const bf16_t*)(ws + WS_U), (bf16_t*)(ws + WS_ACT), KIN(21) + DFF, KIN(22), KIN(23), KIN(6)};
        pg8::gemm_phase<pg8::EpiAct, pg8::StaticOrder, true, true>(lds, g, S, E);
    }
    GSYNC();
    if (DBG_STOP == 8) { DG(WS_ACT, SZ_U, true); return; }
    {
        unsigned char* const ws = KWS();
        pg8::Gemm g{(const bf16_t*)(ws + WS_ACT), (const bf16_t*)(ws + WS_WDN), MP, 1024, DFF}; pg8::TailSplitOrder S; S.init(MP, 1024, G, bx, DFF, 11);
        pg8::EpiZ2 E{(const bf16_t*)(ws + WS_X1B), KIN(25), KOUT(), (float*)(ws + WS_U), S.tail_row0()};
        pg8::gemm_phase<pg8::EpiZ2, pg8::TailSplitOrder, true, true>(lds, g, S, E);
    }
    GSYNC();
    {
        const int gw = bx * 8 + wave, NGW = G * 8;
        const float* lg = KIN(26); const float* lb = KIN(27); float* const outp = KOUT();
        pg8::TailSplitOrder S7; S7.init(MP, 1024, G, bx, DFF, 11); const int ty0 = S7.split_mode ? S7.tail_row0() - 128 : (1 << 30);
        const float* part = (const float*)(KWS() + WS_U);
#define Z2ROW(r_) ((const f32x4*)((r_) >= ty0 ? part + (size_t)((r_) - ty0) * DM : outp + (size_t)(r_) * DM) + lane)
        f32x4 nv[4];
        if (gw < NB * SEQ + RS) { const f32x4* x0 = Z2ROW(gw);
#pragma unroll
            for (int j = 0; j < 4; ++j) nv[j] = x0[64 * j]; }
        for (int r = gw; r < NB * SEQ + RS; r += NGW) {
            f32x4* xr = (f32x4*)(outp + (size_t)r * DM) + lane;
            f32x4 v[4]; float s = 0.f;
#pragma unroll
            for (int j = 0; j < 4; ++j) v[j] = nv[j];
            if (r + NGW < NB * SEQ + RS) { const f32x4* xn = Z2ROW(r + NGW);
#pragma unroll
                for (int j = 0; j < 4; ++j) nv[j] = xn[64 * j]; }
            if (r >= ty0) {
                const f32x4* pr = Z2ROW(r);
                for (int pc = 1; pc < 11; ++pc) {
#pragma unroll
                    for (int j = 0; j < 4; ++j) v[j] += pr[pc * (pg8::PART_STRIDE / 4) + 64 * j]; }
            }
#pragma unroll
            for (int j = 0; j < 4; ++j) s += (v[j].x + v[j].y) + (v[j].z + v[j].w);
            const float mean = wave_sum(s) * (1.f / DM); float s2 = 0.f;
#pragma unroll
            for (int j = 0; j < 4; ++j) { v[j] = v[j] - mean; s2 += (v[j].x * v[j].x + v[j].y * v[j].y) + (v[j].z * v[j].z + v[j].w * v[j].w); }
            const float rstd = 1.f / sqrtf(wave_sum(s2) * (1.f / DM) + LN_EPS);
#pragma unroll
            for (int j = 0; j < 4; ++j) {
                const f32x4 gg = *((const f32x4*)lg + lane + 64 * j), bb = *((const f32x4*)lb + lane + 64 * j);
                xr[64 * j] = v[j] * rstd * gg + bb;
            }
        }
    }
}

extern "C" void kernel_launch(void* const* d_in, const int* in_sizes, int n_in, void* d_out, int out_size, void* d_ws, size_t ws_size, hipStream_t stream) {
    static int grid_blocks = 0;
    if (grid_blocks == 0) {
        int dev = 0, cus = 0, per_cu = 0;
        (void)hipGetDevice(&dev);
        (void)hipDeviceGetAttribute(&cus, hipDeviceAttributeMultiprocessorCount, dev);
        (void)hipFuncSetAttribute((const void*)fwd_kernel, hipFuncAttributeMaxDynamicSharedMemorySize, LDS_BYTES);
        (void)hipOccupancyMaxActiveBlocksPerMultiprocessor(&per_cu, (const void*)fwd_kernel, 512, LDS_BYTES);
        if (per_cu < 1) { fprintf(stderr, "kernel_launch: occupancy query returned %d\n", per_cu); per_cu = 1; }
        grid_blocks = cus * per_cu;
    }
    (void)hipMemsetAsync((unsigned char*)d_ws + WS_SMALL + SM_BAR, 0, 16384, stream);
    Params p{};
    for (int i = 0; i < 28; ++i) p.in[i] = (const float*)d_in[i];
    p.out = (float*)d_out; p.ws = (unsigned char*)d_ws;
    void* args[] = {&p};
    hipError_t e = hipLaunchCooperativeKernel((const void*)fwd_kernel, dim3(grid_blocks), dim3(512), args, LDS_BYTES, stream);
    if (e != hipSuccess) fprintf(stderr, "cooperative launch failed: %s (grid %d)\n", hipGetErrorString(e), grid_blocks);
}
```

```cpp
#include <hip/hip_runtime.h>
#include <hip/hip_cooperative_groups.h>
#include <cstdio>
#include <cstdint>
namespace cg = cooperative_groups;

#define LAS __attribute__((address_space(3)))
typedef unsigned short bf16_t;
typedef short bf16x8 __attribute__((ext_vector_type(8)));
typedef short s16x4 __attribute__((ext_vector_type(4)));
typedef float f32x4 __attribute__((ext_vector_type(4)));
typedef unsigned u32x4 __attribute__((ext_vector_type(4)));
typedef unsigned u32x2 __attribute__((ext_vector_type(2)));

constexpr int DM = 1024, NB = 8, SEQ = 2048, NMETA = 16, TP = SEQ + NMETA, DB = 128, DS = 8;
constexpr int RP = NB * TP;
constexpr int RS = DB * DS;
constexpr int MR = RP + RS;
constexpr int MP = 17664;
constexpr int DFF = 2816, DIN = 4104;
constexpr int NCH = 33;
constexpr int NSLOT = NB * 4 * NCH;
constexpr float ALPHA = 1.189207115002721f;
constexpr float LN_EPS = 1e-5f, RMS_EPS = 1e-6f;
constexpr float KSCALE = 0.08838834764831845f;

constexpr size_t MiB = 1u << 20;
constexpr size_t WS_WIN = 0, WS_WOUT = 8 * MiB, WS_WUP = 10 * MiB, WS_WDN = 21 * MiB;
constexpr size_t WS_SMALL = 27 * MiB;
constexpr size_t SM_STATS = 0;
constexpr size_t SM_IG = 160 * 1024;
constexpr size_t SM_LFA = SM_IG + 288 * 1024;
constexpr size_t SM_CHKL = SM_LFA + 288 * 1024;
constexpr size_t SM_CHKB = SM_CHKL + 8192;
constexpr size_t SM_MIN = SM_CHKB + 8192;
constexpr size_t SM_CHKN = SM_MIN + 8192;
constexpr size_t SM_NIN = SM_CHKN + 544 * 1024;
constexpr size_t SM_CHKA = SM_NIN + 544 * 1024;
constexpr size_t SM_BAR = SM_CHKA + 544 * 1024;
static_assert(SM_BAR + 16384 <= 4 * MiB, "small region");
constexpr size_t WS_BIG = 31 * MiB;
constexpr size_t SZ_R1024 = (size_t)MP * 1024 * 2;
constexpr size_t SZ_R512 = (size_t)MP * 512 * 2;
constexpr size_t SZ_CST = (size_t)NSLOT * 16384 * 2;
constexpr size_t WS_XN = WS_BIG, WS_CSTM = WS_BIG;
constexpr size_t WS_QAB = WS_BIG + SZ_R1024;
constexpr size_t WS_KA = WS_QAB + SZ_R1024, WS_VA = WS_KA + SZ_R512, WS_OA = WS_VA + SZ_R512, WS_IB = WS_OA + SZ_R512, WS_GB = WS_IB + SZ_R512;
constexpr size_t WS_FB = WS_GB + SZ_R512;
constexpr size_t WS_CSTH = WS_FB + SZ_R1024;
static_assert(WS_CSTH + SZ_CST <= 256 * MiB, "ws map (mixer)");
constexpr size_t WS_X1B = WS_BIG;
constexpr size_t WS_Z1 = WS_BIG + 2 * SZ_R1024;
constexpr size_t SZ_U = (size_t)MP * DFF * 2;
constexpr size_t WS_U = WS_BIG + SZ_R1024;
constexpr size_t WS_ACT = WS_U + SZ_U;
static_assert(WS_ACT + SZ_U <= 256 * MiB, "ws map (ffn)");

constexpr size_t O_YP = 0, O_CP = 17825792, O_NP = 18350080, O_MPR = 18354176, O_SP = 18354208, O_CVP = 18878496,
                 O_CS = 18923552, O_NS = 27312160, O_MS = 27377696, O_SS = 27378208, O_CVS = 35766816;

constexpr int LDS_BYTES = 155648;

struct Params { const float* in[28]; float* out; unsigned char* ws; };

typedef float f32x2_t __attribute__((ext_vector_type(2)));
typedef __bf16 bf16x2_t __attribute__((ext_vector_type(2)));
__device__ __forceinline__ unsigned pk2(float lo, float hi) { const f32x2_t v = {lo, hi}; const bf16x2_t b = __builtin_convertvector(v, bf16x2_t); return __builtin_bit_cast(unsigned, b); }
__device__ __forceinline__ unsigned f2bf(float f) { return pk2(f, 0.f) & 0xffffu; }
__device__ __forceinline__ float bflo(unsigned u) { return __uint_as_float(u << 16); }
__device__ __forceinline__ float bfhi(unsigned u) { return __uint_as_float(u & 0xffff0000u); }
__device__ __forceinline__ float bf2f(bf16_t h) { return __uint_as_float(((unsigned)h) << 16); }
__device__ __forceinline__ float wave_sum(float v) {
#pragma unroll
    for (int o = 1; o < 64; o <<= 1) v += __shfl_xor(v, o);
    return v;
}
__device__ __forceinline__ float frcp(float x) { return __builtin_amdgcn_rcpf(x); }
__device__ __forceinline__ float sigmoidf_(float x) { return frcp(1.0f + __expf(-x)); }
__device__ __forceinline__ float siluf_(float x) { return x * frcp(1.0f + __expf(-x)); }
__device__ __forceinline__ f32x4 sigmoid4(const f32x4 x) {
    const f32x4 t = x * (-1.4426950408889634f);
    f32x4 e; e[0] = __builtin_amdgcn_exp2f(t[0]); e[1] = __builtin_amdgcn_exp2f(t[1]); e[2] = __builtin_amdgcn_exp2f(t[2]); e[3] = __builtin_amdgcn_exp2f(t[3]);
    const f32x4 d = e + 1.0f;
    f32x4 r; r[0] = __builtin_amdgcn_rcpf(d[0]); r[1] = __builtin_amdgcn_rcpf(d[1]); r[2] = __builtin_amdgcn_rcpf(d[2]); r[3] = __builtin_amdgcn_rcpf(d[3]);
    return r;
}
__device__ __forceinline__ const float* xrow_ptr(const float* xp, const float* xs, const float* meta, int r) {
    if (r < RP) { const int b = r / TP, q = r - b * TP; return q < NMETA ? meta + (size_t)q * DM : xp + ((size_t)b * SEQ + (q - NMETA)) * DM; }
    return xs + (size_t)(r - RP) * DM;
}
typedef __attribute__((address_space(4))) const Params* KP;
__device__ __forceinline__ KP kparams() { KP k = (KP)__builtin_amdgcn_kernarg_segment_ptr(); asm volatile("" : "+s"(k)); return k; }
#define KIN(i) (kparams()->in[i])
#define KOUT() (kparams()->out)
#define KWS() (kparams()->ws)

namespace pg8 {
constexpr int BM = 256, BK = 64, HALF = 128, HTB = HALF * BK * 2, STAGE_BYTES = 8 * HTB, NXCD = 8, WGM = 8;
__host__ __device__ __forceinline__ int lds_byte(int r, int c) { const int st = (r >> 4) * 2 + (c >> 5), rr = r & 15, cc = c & 31, ob = rr * 64 + cc * 2; return st * 1024 + (ob ^ (((ob >> 9) & 1) << 5)); }
__host__ __device__ __forceinline__ void stage_rc(int b, int& R, int& C) { const int st = b / 1024, sb = b % 1024, swz = sb ^ (((sb >> 9) & 1) << 5); R = (st >> 1) * 16 + swz / 64; C = (st & 1) * 32 + (swz % 64) / 2; }
__host__ __device__ __forceinline__ int perm32(int rho) { const int n = rho >> 4, i = rho & 15; return 8 * (i >> 2) + 4 * n + (i & 3); }
struct Unit { int pm, pn, k0, nk, split; };
struct Gemm { const bf16_t* A; const bf16_t* Bt; int M, N, K; };
struct StaticOrder {
    int nM, nN, nwg, G, c, ntk;
    __host__ __device__ void init(int M, int N, int G_, int c_, int K_ = 1024) { nM = M / BM; nN = N / BM; nwg = nM * nN; G = G_; c = c_; ntk = K_ / BK; }
    __host__ __device__ bool next(int i, Unit& u) const {
        u.k0 = 0; u.nk = ntk; u.split = 0;
        const long L = (long)i * G + c; if (L >= nwg) return false;
        int wgid = (int)L; { const int q = nwg / NXCD, r = nwg % NXCD, xcd = wgid % NXCD, off = wgid / NXCD; wgid = (xcd < r ? xcd * (q + 1) : r * (q + 1) + (xcd - r) * q) + off; }
        const int nig = WGM * nN, gid = wgid / nig, fm = gid * WGM, gsz = (nM - fm) < WGM ? (nM - fm) : WGM;
        u.pm = fm + ((wgid % nig) % gsz); u.pn = (wgid % nig) / gsz; return true;
    }
    __device__ __forceinline__ void a_ready(const Unit&) const {}
    __device__ __forceinline__ void done(const Unit&) const {}
};
__host__ __device__ __forceinline__ void map_unit(int wgid, int nM, int nN, int nwg, Unit& u) {
    { const int q = nwg / NXCD, r = nwg % NXCD, xcd = wgid % NXCD, off = wgid / NXCD; wgid = (xcd < r ? xcd * (q + 1) : r * (q + 1) + (xcd - r) * q) + off; }
    const int nig = WGM * nN, gid = wgid / nig, fm = gid * WGM, gsz = (nM - fm) < WGM ? (nM - fm) : WGM;
    u.pm = fm + ((wgid % nig) % gsz); u.pn = (wgid % nig) / gsz;
}
struct TailSplitOrder {
    int nM, nN, nwg, G, c, ntk, S, split_mode, nMf;
    __host__ __device__ __forceinline__ void init(int M, int N, int G_, int c_, int K_, int S_) {
        nM = M / BM; nN = N / BM; nwg = nM * nN; G = G_; c = c_; ntk = K_ / BK; S = S_; nMf = G_ / nN;
        const int R = nwg - G_;
        split_mode = (G_ % nN == 0) && R > 0 && R * S_ <= G_ && (ntk % (2 * S_) == 0);
    }
    __host__ __device__ __forceinline__ int tail_row0() const { return split_mode ? nMf * BM : (1 << 30); }
    __host__ __device__ __forceinline__ bool next(int i, Unit& u) const {
        u.k0 = 0; u.nk = ntk; u.split = 0;
        if (!split_mode) { const long L = (long)i * G + c; if (L >= nwg) return false; map_unit((int)L, nM, nN, nwg, u); return true; }
        if (i == 0) { map_unit(c, nMf, nN, G, u); return true; }
        if (i > 1) return false;
        const int R = nwg - G; if (c >= R * S) return false;
        const int t = c / S, piece = c - t * S;
        u.pm = nMf + t / nN; u.pn = t % nN; u.nk = ntk / S; u.k0 = piece * u.nk; u.split = piece + 1; return true;
    }
    __device__ __forceinline__ void a_ready(const Unit&) const {}
    __device__ __forceinline__ void done(const Unit&) const {}
};
__device__ __forceinline__ void atomic_add4(float* o, const f32x4 v) {
#pragma unroll
    for (int j = 0; j < 4; ++j) __hip_atomic_fetch_add(o + j, v[j], __ATOMIC_RELAXED, __HIP_MEMORY_SCOPE_AGENT);
}
__device__ __forceinline__ unsigned cvt_pk_bf16(float lo, float hi) { unsigned r; asm volatile("v_cvt_pk_bf16_f32 %0, %1, %2" : "=v"(r) : "v"(lo), "v"(hi)); return r; }

template <class Epi, class Sched, bool ALIGN_EPI = false, bool SP2 = false>
__device__ __forceinline__ void gemm_phase(LAS unsigned char* lds, const Gemm g, const Sched& S, const Epi& E) {
    int tid_l = threadIdx.x; asm volatile("" : "+v"(tid_l));
    const int tid = tid_l, wid = __builtin_amdgcn_readfirstlane(tid >> 6), lane = tid & 63, wr = wid >> 2, wc = wid & 3, fr = lane & 15, fq = lane >> 4;
    const int K = g.K;
    unsigned voffA[2], voffB[2];
#pragma unroll
    for (int i = 0; i < 2; ++i) { int R, C; stage_rc(tid * 16 + i * 8192, R, C); const int Rb = Epi::PERM ? ((R & ~31) + perm32(R & 31)) : R;
        voffA[i] = (unsigned)(R * K + C) * 2u; voffB[i] = (unsigned)(Rb * K + C) * 2u; }
    const size_t kstep = (size_t)(BK * 2);
    const size_t hstep = (size_t)HALF * K * 2;
    const size_t tstep = 2 * hstep;
    const unsigned ldsw = (unsigned)wid * 1024u;
    const int aoff = lds_byte(wr * 64 + fr, fq * 8), boff = lds_byte(wc * 32 + fr, fq * 8);
#define PG8_SA(b, h) (((b) * 2 + (h)) * HTB)
#define PG8_SB(b, h) ((4 + (b) * 2 + (h)) * HTB)
#define PG8_STAGE(bufoff, gbase, voff) do { _Pragma("unroll") for (int _i = 0; _i < 2; ++_i) \
        __builtin_amdgcn_global_load_lds((const unsigned*)((const char*)(gbase) + (voff)[_i]), (LAS unsigned*)(lds + (bufoff) + ldsw + _i * 8192), 16, 0, 0); } while (0)
#define PG8_LDA(dst, b, h) do { _Pragma("unroll") for (int m = 0; m < 4; ++m) _Pragma("unroll") for (int k = 0; k < 2; ++k) dst[m][k] = *(const LAS bf16x8*)(lds + PG8_SA(b, h) + aoff + m * 2048 + k * 1024); } while (0)
#define PG8_LDB(dst, b, h) do { _Pragma("unroll") for (int n = 0; n < 2; ++n) _Pragma("unroll") for (int k = 0; k < 2; ++k) dst[n][k] = *(const LAS bf16x8*)(lds + PG8_SB(b, h) + boff + n * 2048 + k * 1024); } while (0)
#define PG8_MMA(ai, bj, At, Bt) do { __builtin_amdgcn_s_setprio(1); _Pragma("unroll") for (int m = 0; m < 4; ++m) _Pragma("unroll") for (int n = 0; n < 2; ++n) _Pragma("unroll") for (int k = 0; k < 2; ++k) \
        acc[ai][bj][m][n] = __builtin_amdgcn_mfma_f32_16x16x32_bf16(Bt[n][k], At[m][k], acc[ai][bj][m][n], 0, 0, 0); __builtin_amdgcn_s_setprio(0); } while (0)
#define PG8_WAIT_V(n) asm volatile("s_waitcnt vmcnt(" #n ")" ::: "memory")
#define PG8_WAIT_L(n) asm volatile("s_waitcnt lgkmcnt(" #n ")" ::: "memory")
#define PG8_BAR __builtin_amdgcn_s_barrier()
#define PG8_SCHED __builtin_amdgcn_sched_barrier(0)
    Unit cur, nxt; int ui = 0;
    if (!S.next(0, cur)) return;
    f32x4 acc[2][2][4][2];
#pragma unroll
    for (int a = 0; a < 2; ++a)
#pragma unroll
        for (int b = 0; b < 2; ++b)
#pragma unroll
            for (int m = 0; m < 4; ++m)
#pragma unroll
                for (int n = 0; n < 2; ++n) acc[a][b][m][n] = (f32x4){0.f, 0.f, 0.f, 0.f};
    bf16x8 At[4][2], B0[2][2], B1[2][2];
    const char* cA = (const char*)g.A + (size_t)cur.pm * tstep + (size_t)cur.k0 * kstep; const char* cB = (const char*)g.Bt + (size_t)cur.pn * tstep + (size_t)cur.k0 * kstep;
    S.a_ready(cur);
    if constexpr (SP2) {
        PG8_STAGE(PG8_SB(0, 0), cB, voffB); PG8_STAGE(PG8_SB(0, 1), cB + hstep, voffB); PG8_STAGE(PG8_SA(0, 0), cA, voffA); PG8_STAGE(PG8_SA(0, 1), cA + hstep, voffA);
        if (wr == 1) PG8_BAR;
        PG8_WAIT_V(2); PG8_BAR;
        PG8_STAGE(PG8_SB(1, 0), cB + kstep, voffB); PG8_STAGE(PG8_SA(1, 0), cA + kstep, voffA); PG8_STAGE(PG8_SB(1, 1), cB + hstep + kstep, voffB);
        PG8_WAIT_V(6); PG8_BAR;
    } else {
        PG8_STAGE(PG8_SB(0, 0), cB, voffB); PG8_STAGE(PG8_SA(0, 0), cA, voffA); PG8_STAGE(PG8_SB(0, 1), cB + hstep, voffB); PG8_STAGE(PG8_SA(0, 1), cA + hstep, voffA);
        if (wr == 1) PG8_BAR;
        PG8_WAIT_V(4); PG8_BAR;
        PG8_STAGE(PG8_SB(1, 0), cB + kstep, voffB); PG8_STAGE(PG8_SA(1, 0), cA + kstep, voffA); PG8_STAGE(PG8_SB(1, 1), cB + hstep + kstep, voffB);
        PG8_WAIT_V(6); PG8_BAR;
    }
    for (;;) {
        const bool has_next = S.next(ui + 1, nxt);
        const char* nA = has_next ? (const char*)g.A + (size_t)nxt.pm * tstep + (size_t)nxt.k0 * kstep : cA; const char* nB = has_next ? (const char*)g.Bt + (size_t)nxt.pn * tstep + (size_t)nxt.k0 * kstep : cB;
        const int nt = cur.nk;
        for (int t = 0; t < nt; t += 2) {
            const bool last = (t == nt - 2);
            const char* a1 = cA + (size_t)(t + 1) * kstep;
            const char* a2 = last ? nA : cA + (size_t)(t + 2) * kstep; const char* b2 = last ? nB : cB + (size_t)(t + 2) * kstep;
            const char* a3 = a2 + kstep; const char* b3 = b2 + kstep;
            if (last && has_next) S.a_ready(nxt);
            if constexpr (SP2) {
            PG8_LDB(B0, 0, 0); PG8_LDB(B1, 0, 1); PG8_SCHED; PG8_LDA(At, 0, 0); PG8_STAGE(PG8_SA(1, 1), a1 + hstep, voffA);
            PG8_WAIT_V(8); PG8_WAIT_L(0); PG8_BAR; PG8_MMA(0, 0, At, B0); PG8_MMA(0, 1, At, B1); PG8_BAR; PG8_SCHED;
            PG8_LDA(At, 0, 1); PG8_STAGE(PG8_SB(0, 0), b2, voffB); PG8_STAGE(PG8_SB(0, 1), b2 + hstep, voffB); PG8_STAGE(PG8_SA(0, 0), a2, voffA);
            PG8_WAIT_V(8); PG8_WAIT_L(0); PG8_BAR; PG8_MMA(1, 0, At, B0); PG8_MMA(1, 1, At, B1); PG8_BAR; PG8_SCHED;
            PG8_LDB(B0, 1, 0); PG8_LDB(B1, 1, 1); PG8_SCHED; PG8_LDA(At, 1, 0); PG8_STAGE(PG8_SA(0, 1), a2 + hstep, voffA);
            PG8_WAIT_V(8); PG8_WAIT_L(0); PG8_BAR; PG8_MMA(0, 0, At, B0); PG8_MMA(0, 1, At, B1); PG8_BAR; PG8_SCHED;
            PG8_LDA(At, 1, 1); PG8_STAGE(PG8_SB(1, 0), b3, voffB); PG8_STAGE(PG8_SB(1, 1), b3 + hstep, voffB); PG8_STAGE(PG8_SA(1, 0), a3, voffA);
            PG8_WAIT_V(8); PG8_WAIT_L(0); PG8_BAR; PG8_MMA(1, 0, At, B0); PG8_MMA(1, 1, At, B1); PG8_BAR; PG8_SCHED;
            } else {
            PG8_LDB(B0, 0, 0); PG8_SCHED; PG8_LDA(At, 0, 0); PG8_STAGE(PG8_SA(1, 1), a1 + hstep, voffA);
            PG8_WAIT_L(8); PG8_BAR; PG8_WAIT_L(0); PG8_MMA(0, 0, At, B0); PG8_BAR; PG8_SCHED;
            PG8_LDB(B1, 0, 1); PG8_STAGE(PG8_SB(0, 0), b2, voffB);
            PG8_BAR; PG8_WAIT_L(0); PG8_MMA(0, 1, At, B1); PG8_BAR;
            PG8_LDA(At, 0, 1); PG8_STAGE(PG8_SA(0, 0), a2, voffA);
            PG8_BAR; PG8_WAIT_L(0); PG8_MMA(1, 0, At, B0); PG8_BAR; PG8_SCHED;
            PG8_STAGE(PG8_SB(0, 1), b2 + hstep, voffB);
            PG8_WAIT_V(6); PG8_BAR; PG8_MMA(1, 1, At, B1); PG8_BAR;
            PG8_LDB(B0, 1, 0); PG8_SCHED; PG8_LDA(At, 1, 0); PG8_STAGE(PG8_SA(0, 1), a2 + hstep, voffA);
            PG8_WAIT_L(8); PG8_BAR; PG8_WAIT_L(0); PG8_MMA(0, 0, At, B0); PG8_BAR; PG8_SCHED;
            PG8_LDB(B1, 1, 1); PG8_STAGE(PG8_SB(1, 0), b3, voffB);
            PG8_BAR; PG8_WAIT_L(0); PG8_MMA(0, 1, At, B1); PG8_BAR;
            PG8_LDA(At, 1, 1); PG8_STAGE(PG8_SA(1, 0), a3, voffA);
            PG8_BAR; PG8_WAIT_L(0); PG8_MMA(1, 0, At, B0); PG8_BAR; PG8_SCHED;
            PG8_STAGE(PG8_SB(1, 1), b3 + hstep, voffB);
            PG8_WAIT_V(6); PG8_BAR; PG8_MMA(1, 1, At, B1); PG8_BAR;
            }
        }
        if constexpr (ALIGN_EPI) { if (wr == 0) PG8_BAR; }
        E(acc, cur, wr, wc, fr, fq);
        if (!has_next) break;
#pragma unroll
        for (int a = 0; a < 2; ++a)
#pragma unroll
            for (int b = 0; b < 2; ++b)
#pragma unroll
                for (int m = 0; m < 4; ++m)
#pragma unroll
                    for (int n = 0; n < 2; ++n) acc[a][b][m][n] = (f32x4){0.f, 0.f, 0.f, 0.f};
        cur = nxt; cA = nA; cB = nB; ++ui;
        if constexpr (ALIGN_EPI) { if (wr == 1) PG8_BAR; }
    }
    PG8_WAIT_V(0);
    if constexpr (!ALIGN_EPI) { if (wr == 0) PG8_BAR; }
    PG8_BAR;
#undef PG8_SA
#undef PG8_SB
#undef PG8_STAGE
#undef PG8_LDA
#undef PG8_LDB
#undef PG8_MMA
#undef PG8_WAIT_V
#undef PG8_WAIT_L
#undef PG8_BAR
#undef PG8_SCHED
}

typedef f32x4 Acc[2][2][4][2];
constexpr size_t PART_STRIDE = (size_t)1280 * 1024;

struct EpiIn {
    static constexpr bool PERM = true;
    unsigned char* ws; const float* b_in;
    __device__ __forceinline__ void operator()(const Acc& acc, const Unit& u, int wr, int wc, int fr, int fq) const {
        const int g = u.pn >> 1;
        const int cg0 = (u.pn & 1) * 256 + wc * 32 + 8 * fq;
        const int bsrc0 = u.pn * 256 + wc * 32 + 8 * fq + (u.pn >= 8 ? 8 : 0);
        const int row0 = u.pm * BM + wr * 64 + fr;
        int mode = 0; size_t ld = 512; unsigned char* base;
        switch (g) {
            case 0: base = ws + WS_QAB; ld = 1024; break;
            case 1: base = ws + WS_KA; mode = 1; break;
            case 2: base = ws + WS_VA; break;
            case 3: base = ws + WS_OA; mode = 3; break;
            case 4: base = ws + WS_QAB + 1024; ld = 1024; mode = 2; break;
            case 5: base = ws + WS_FB; mode = 4; break;
            case 6: base = ws + WS_IB; break;
            default: base = ws + WS_GB; mode = 3; break;
        }
#pragma unroll
        for (int bj = 0; bj < 2; ++bj) {
            const f32x4 b0 = *(const f32x4*)(b_in + bsrc0 + bj * HALF), b1 = *(const f32x4*)(b_in + bsrc0 + bj * HALF + 4);
#pragma unroll
            for (int ai = 0; ai < 2; ++ai)
#pragma unroll
                for (int m = 0; m < 4; ++m) {
                    const size_t row = (size_t)(row0 + ai * HALF + m * 16);
                    f32x4 v0 = acc[ai][bj][m][0] + b0, v1 = acc[ai][bj][m][1] + b1;
                    if (mode == 4) { float* o = (float*)base + row * 512 + cg0 + bj * HALF; *(f32x4*)o = v0; *(f32x4*)(o + 4) = v1; continue; }
                    if (mode == 1) { v0 = v0 * KSCALE; v1 = v1 * KSCALE; }
                    else if (mode == 2) { v0 = v0 * sigmoid4(v0); v1 = v1 * sigmoid4(v1); }
                    else if (mode == 3) { v0 = sigmoid4(v0); v1 = sigmoid4(v1); }
                    u32x4 w; w.x = cvt_pk_bf16(v0[0], v0[1]); w.y = cvt_pk_bf16(v0[2], v0[3]); w.z = cvt_pk_bf16(v1[0], v1[1]); w.w = cvt_pk_bf16(v1[2], v1[3]);
                    *(u32x4*)((bf16_t*)base + row * ld + cg0 + bj * HALF) = w;
                }
        }
    }
};

struct EpiZ1 {
    static constexpr bool PERM = true;
    const float* xp; const float* xs; const float* meta; const float* gg; const float* gb; const float* bo; const float* stats; float* z1; float* tail; int tailrow0;
    __device__ __forceinline__ void operator()(const Acc& acc, const Unit& u, int wr, int wc, int fr, int fq) const {
        const int col0 = u.pn * BM + wc * 32 + 8 * fq;
#pragma unroll
        for (int bj = 0; bj < 2; ++bj) {
            const int col = col0 + bj * HALF;
            const f32x4 g0 = *(const f32x4*)(gg + col), g1 = *(const f32x4*)(gg + col + 4);
            const f32x4 c0 = *(const f32x4*)(gb + col) * ALPHA + *(const f32x4*)(bo + col), c1 = *(const f32x4*)(gb + col + 4) * ALPHA + *(const f32x4*)(bo + col + 4);
#pragma unroll
            for (int am = 0; am < 2; ++am) { const int ai = am, mb = 0;
                f32x4 xa[4], xb[4]; float mus[4], rss[4];
#pragma unroll
                for (int mm = 0; mm < 4; ++mm) { const int row = u.pm * BM + ai * HALF + wr * 64 + (mb + mm) * 16 + fr;
                    xa[mm] = (f32x4){0.f, 0.f, 0.f, 0.f}; xb[mm] = xa[mm]; mus[mm] = 0.f; rss[mm] = 0.f;
                    if (row < MR && u.split <= 1) { const float* xr = xrow_ptr(xp, xs, meta, row) + col; xa[mm] = *(const f32x4*)xr; xb[mm] = *(const f32x4*)(xr + 4); mus[mm] = stats[2 * row]; rss[mm] = stats[2 * row + 1] * ALPHA; } }
#pragma unroll
                for (int mm = 0; mm < 4; ++mm) { const int m = mb + mm;
                    const int row = u.pm * BM + ai * HALF + wr * 64 + m * 16 + fr;
                    f32x4 v0 = (f32x4){0.f, 0.f, 0.f, 0.f}, v1 = v0;
                    if (row < MR) {
                        v0 = acc[ai][bj][m][0]; v1 = acc[ai][bj][m][1];
                        if (u.split <= 1) { v0 = v0 + c0 + (xa[mm] - mus[mm]) * rss[mm] * g0; v1 = v1 + c1 + (xb[mm] - mus[mm]) * rss[mm] * g1; }
                    }
                    float* o = (u.split ? tail + (size_t)(u.split - 1) * PART_STRIDE + (size_t)(row - tailrow0) * DM : z1 + (size_t)row * DM) + col;
                    *(f32x4*)o = v0; *(f32x4*)(o + 4) = v1;
                }
            }
        }
    }
};

struct EpiU {
    static constexpr bool PERM = true;
    bf16_t* U; const float* b_up; float* out;
    __device__ __forceinline__ void operator()(const Acc& acc, const Unit& u, int wr, int wc, int fr, int fq) const {
        const int col0 = u.pn * BM + wc * 32 + 8 * fq;
#pragma unroll
        for (int bj = 0; bj < 2; ++bj) {
            const int col = col0 + bj * HALF;
            const f32x4 b0 = *(const f32x4*)(b_up + col), b1 = *(const f32x4*)(b_up + col + 4);
#pragma unroll
            for (int ai = 0; ai < 2; ++ai)
#pragma unroll
                for (int m = 0; m < 4; ++m) {
                    const int row = u.pm * BM + ai * HALF + wr * 64 + m * 16 + fr;
                    const f32x4 v0 = acc[ai][bj][m][0] + b0, v1 = acc[ai][bj][m][1] + b1;
                    u32x4 w; w.x = cvt_pk_bf16(v0[0], v0[1]); w.y = cvt_pk_bf16(v0[2], v0[3]); w.z = cvt_pk_bf16(v1[0], v1[1]); w.w = cvt_pk_bf16(v1[2], v1[3]);
                    *(u32x4*)(U + (size_t)row * DFF + col) = w;
                    float* o = nullptr;
                    if (row < RP) { const int b = row / TP, q = row - b * TP; if (q >= TP - 2) o = out + O_CVP + ((size_t)(b * 2 + (q - (TP - 2)))) * DFF + col; }
                    else if (row < MR) { const int s = row - RP, t = s & 7; if (t >= 6) o = out + O_CVS + ((size_t)((s >> 3) * 2 + (t - 6))) * DFF + col; }
                    if (o) { *(f32x4*)o = v0; *(f32x4*)(o + 4) = v1; }
                }
        }
    }
};

__device__ __forceinline__ f32x4 silu_mul4(const f32x4 x, const f32x4 g) {
    const f32x4 t = x * (-1.4426950408889634f);
    f32x4 e; e[0] = __builtin_amdgcn_exp2f(t[0]); e[1] = __builtin_amdgcn_exp2f(t[1]); e[2] = __builtin_amdgcn_exp2f(t[2]); e[3] = __builtin_amdgcn_exp2f(t[3]);
    const f32x4 d = e + 1.0f;
    f32x4 r; r[0] = __builtin_amdgcn_rcpf(d[0]); r[1] = __builtin_amdgcn_rcpf(d[1]); r[2] = __builtin_amdgcn_rcpf(d[2]); r[3] = __builtin_amdgcn_rcpf(d[3]);
    return (x * r) * g;
}
__device__ __forceinline__ void unpack8(const u32x4 w, f32x4& a, f32x4& b) { a = (f32x4){bflo(w.x), bfhi(w.x), bflo(w.y), bfhi(w.y)}; b = (f32x4){bflo(w.z), bfhi(w.z), bflo(w.w), bfhi(w.w)}; }
struct EpiAct {
    static constexpr bool PERM = true;
    const bf16_t* U; bf16_t* ACT; const float* b_upg; const float* w_conv; const float* b_conv; const float* cstate;
    __device__ __forceinline__ void operator()(const Acc& acc, const Unit& u, int wr, int wc, int fr, int fq) const {
        const int col0 = u.pn * BM + wc * 32 + 8 * fq;
#pragma unroll
        for (int bj = 0; bj < 2; ++bj) {
            const int col = col0 + bj * HALF;
            const f32x4 bg0 = *(const f32x4*)(b_upg + col), bg1 = *(const f32x4*)(b_upg + col + 4);
            const f32x4 bc0 = *(const f32x4*)(b_conv + col), bc1 = *(const f32x4*)(b_conv + col + 4);
            const f32x4 wa0 = *(const f32x4*)(w_conv + col), wa1 = *(const f32x4*)(w_conv + col + 4);
            const f32x4 wb0 = *(const f32x4*)(w_conv + DFF + col), wb1 = *(const f32x4*)(w_conv + DFF + col + 4);
            const f32x4 wc0 = *(const f32x4*)(w_conv + 2 * DFF + col), wc1 = *(const f32x4*)(w_conv + 2 * DFF + col + 4);
#pragma unroll
            for (int ai = 0; ai < 2; ++ai) {
                u32x4 own[4], halo = (u32x4){0u, 0u, 0u, 0u};
                const int hb = u.pm * BM + ai * HALF + wr * 64;
                own[0] = *(const u32x4*)(U + (size_t)(hb + fr) * DFF + col); own[1] = *(const u32x4*)(U + (size_t)(hb + 16 + fr) * DFF + col);
                if (fr >= 14) halo = *(const u32x4*)(U + (long)(hb - (16 - fr)) * DFF + col);
#pragma unroll
                for (int m = 0; m < 4; ++m) {
                    if (m == 1) { own[2] = *(const u32x4*)(U + (size_t)(hb + 32 + fr) * DFF + col); own[3] = *(const u32x4*)(U + (size_t)(hb + 48 + fr) * DFF + col); }
                    const int row = hb + m * 16 + fr;
                    const u32x4 prev = m ? own[m - 1] : halo;
                    u32x4 w1, w2;
#pragma unroll
                    for (int k = 0; k < 4; ++k) {
                        const int pr1 = __builtin_amdgcn_update_dpp(0, (int)prev[k], 0x121, 0xF, 0xF, true);
                        const int pr2 = __builtin_amdgcn_update_dpp(0, (int)prev[k], 0x122, 0xF, 0xF, true);
                        w1[k] = (unsigned)__builtin_amdgcn_update_dpp(pr1, (int)own[m][k], 0x111, 0xF, 0xF, false);
                        w2[k] = (unsigned)__builtin_amdgcn_update_dpp(pr2, (int)own[m][k], 0x112, 0xF, 0xF, false);
                    }
                    int t = 2;
                    if (row < RP) { const int b = row / TP; t = row - b * TP; } else if (row < MR) t = (row - RP) & 7;
                    f32x4 u00, u01, u10, u11, u20, u21;
                    unpack8(own[m], u00, u01); unpack8(w1, u10, u11); unpack8(w2, u20, u21);
                    if (__builtin_amdgcn_ballot_w64(t < 2) != 0ull) {
                        if (t < 1) { u10 = (f32x4){0.f, 0.f, 0.f, 0.f}; u11 = u10; }
                        if (t < 2) { u20 = (f32x4){0.f, 0.f, 0.f, 0.f}; u21 = u20; }
                        if (row >= RP && row < MR && t < 2) { const int s = row - RP;
                            const float* cs = cstate + (size_t)(s >> 3) * 2 * DFF + col;
                            const float* c2 = cs + (t == 1 ? DFF : 0); u20 = *(const f32x4*)c2; u21 = *(const f32x4*)(c2 + 4);
                            if (t == 0) { u10 = *(const f32x4*)(cs + DFF); u11 = *(const f32x4*)(cs + DFF + 4); } }
                    }
                    f32x4 cv0 = bc0 + wa0 * u20 + wb0 * u10 + wc0 * u00, cv1 = bc1 + wa1 * u21 + wb1 * u11 + wc1 * u01;
                    const f32x4 g0 = acc[ai][bj][m][0] + bg0, g1 = acc[ai][bj][m][1] + bg1;
                    cv0 = silu_mul4(cv0, g0); cv1 = silu_mul4(cv1, g1);
                    u32x4 w; w.x = cvt_pk_bf16(cv0[0], cv0[1]); w.y = cvt_pk_bf16(cv0[2], cv0[3]); w.z = cvt_pk_bf16(cv1[0], cv1[1]); w.w = cvt_pk_bf16(cv1[2], cv1[3]);
                    *(u32x4*)(ACT + (size_t)row * DFF + col) = w;
                }
            }
        }
    }
};

struct EpiZ2 {
    static constexpr bool PERM = true;
    const bf16_t* X1B; const float* b_dn; float* out; float* part; int tailrow0;
    __device__ __forceinline__ void operator()(const Acc& acc, const Unit& u, int wr, int wc, int fr, int fq) const {
        const int col0 = u.pn * BM + wc * 32 + 8 * fq;
#pragma unroll
        for (int bj = 0; bj < 2; ++bj) {
            const int col = col0 + bj * HALF;
            const f32x4 b0 = *(const f32x4*)(b_dn + col), b1 = *(const f32x4*)(b_dn + col + 4);
#pragma unroll
            for (int ai = 0; ai < 2; ++ai) {
                u32x4 xr[4];
#pragma unroll
                for (int m = 0; m < 4; ++m) xr[m] = *(const u32x4*)(X1B + (size_t)(u.pm * BM + ai * HALF + wr * 64 + m * 16 + fr) * DM + col);
#pragma unroll
                for (int m = 0; m < 4; ++m) {
                    const int row = u.pm * BM + ai * HALF + wr * 64 + m * 16 + fr;
                    long yrow = -1;
                    if (row < RP) { const int b = row / TP, q = row - b * TP; if (q >= NMETA) yrow = (long)b * SEQ + (q - NMETA); }
                    else if (row < MR) yrow = (long)NB * SEQ + (row - RP);
                    if (yrow >= 0 || u.split) {
                        f32x4 v0 = acc[ai][bj][m][0], v1 = acc[ai][bj][m][1];
                        if (u.split <= 1) { f32x4 x0, x1; unpack8(xr[m], x0, x1); v0 = v0 + b0 + x0 * ALPHA; v1 = v1 + b1 + x1 * ALPHA; }
                        float* o = (u.split ? part + (size_t)(u.split - 1) * PART_STRIDE + (size_t)(row - tailrow0) * DM : out + (size_t)yrow * DM) + col;
                        *(f32x4*)o = v0; *(f32x4*)(o + 4) = v1;
                    }
                }
            }
        }
    }
};
}

constexpr int LQ = 0, LK = 17408, LV = 34816, LC = 52224, LSW = 87040, LA = 96256, LVEC = 129024;
constexpr int RSTR = 272, SWSTR = 144;
constexpr int V_BM = 0, V_AV = 64, V_DEC = 128, V_EM = 192, V_DENQ = 256, V_DENI = 320, V_SSQ = 384, V_WT = 448, V_NIN = 512, V_PSUM = 640, V_MISC = 1152;
constexpr int LG = LVEC + (V_MISC + 16) * 4;
constexpr int LGN = LG + 64 * RSTR;
static_assert(LG % 16 == 0 && LGN % 16 == 0 && LGN + 4096 <= LDS_BYTES - 16, "mixer LDS map");

__device__ __forceinline__ bf16x8 rowfrag(LAS unsigned char* base, int stride, int row0, int k0, int lane) {
    return *(const LAS bf16x8*)(base + (row0 + (lane & 15)) * stride + (k0 + 8 * (lane >> 4)) * 2);
}
__device__ __forceinline__ bf16x8 trfrag(LAS unsigned char* base, int stride, int k0, int c0, int lane) {
    const int g = lane >> 4, q = (lane & 15) >> 2, pp = lane & 3;
    LAS unsigned char* a = base + (k0 + 8 * g + q) * stride + (c0 + 4 * pp) * 2;
    const s16x4 lo = __builtin_amdgcn_ds_read_tr16_b64_v4i16((LAS s16x4*)a);
    const s16x4 hi = __builtin_amdgcn_ds_read_tr16_b64_v4i16((LAS s16x4*)(a + 4 * stride));
    return (bf16x8){lo[0], lo[1], lo[2], lo[3], hi[0], hi[1], hi[2], hi[3]};
}
__device__ __forceinline__ void load_chunk(LAS unsigned char* dst, const bf16_t* src, size_t ldg, int len, int tid) {
#pragma unroll
    for (int i = 0; i < 2; ++i) { const int q = tid + i * 512, s = q >> 4, cc = q & 15;
        u32x4 v = (u32x4){0u, 0u, 0u, 0u}; if (s < len) v = *(const u32x4*)(src + (size_t)s * ldg + cc * 8);
        *(LAS u32x4*)(dst + s * RSTR + cc * 16) = v; }
}
__device__ __forceinline__ void chunk_ld(u32x4 (&r)[2], const bf16_t* src, size_t ldg, int len, int tid) {
#pragma unroll
    for (int i = 0; i < 2; ++i) { const int q = tid + i * 512, s = q >> 4, cc = q & 15; r[i] = (u32x4){0u, 0u, 0u, 0u}; if (s < len) r[i] = *(const u32x4*)(src + (size_t)s * ldg + cc * 8); }
}
__device__ __forceinline__ void chunk_st(LAS unsigned char* dst, const u32x4 (&r)[2], int tid) {
#pragma unroll
    for (int i = 0; i < 2; ++i) { const int q = tid + i * 512, s = q >> 4, cc = q & 15; *(LAS u32x4*)(dst + s * RSTR + cc * 16) = r[i]; }
}
__device__ __forceinline__ void fb_ld(f32x4 (&fbv)[4], const float* FBsrc, int len, int tid) {
    const int c4 = tid & 31, sr = tid >> 5;
#pragma unroll
    for (int j = 0; j < 4; ++j) { const int s = sr + 16 * j; fbv[j] = (f32x4){0.f, 0.f, 0.f, 0.f}; if (s < len) fbv[j] = *(const f32x4*)(FBsrc + (size_t)s * 512 + c4 * 4); }
}
__device__ __forceinline__ void hgrn_prep(LAS unsigned char* lds, const f32x4 (&fbv)[4], const float* lbl, int h, int len, int tid) {
    LAS float* A = (LAS float*)(lds + LA); LAS float* vec = (LAS float*)(lds + LVEC);
    const int cch = tid & 127, part = tid >> 7;
    { const int c4 = tid & 31, sr = tid >> 5;
      const f32x4 l0 = *(const f32x4*)(lbl + h * 128 + c4 * 4), l1 = *(const f32x4*)(lbl + 512 + h * 128 + c4 * 4);
      f32x4 lb4;
#pragma unroll
      for (int k = 0; k < 4; ++k) lb4[k] = frcp(1.0f + __expf(l1[k] - l0[k]));
#pragma unroll
      for (int j = 0; j < 4; ++j) { const int s = sr + 16 * j;
        f32x4 lf = (f32x4){0.f, 0.f, 0.f, 0.f}, kb = lf;
        if (s < len) {
#pragma unroll
            for (int k = 0; k < 4; ++k) { const float sg = frcp(1.0f + __expf(-fbv[j][k])); const float f = lb4[k] + (1.0f - lb4[k]) * sg; lf[k] = __logf(f); kb[k] = (1.0f - lb4[k]) * (1.0f - sg); } }
        *(LAS f32x4*)(A + s * 128 + c4 * 4) = lf;
        u32x2 w; w.x = pk2(kb[0], kb[1]); w.y = pk2(kb[2], kb[3]); *(LAS u32x2*)(lds + LK + s * RSTR + c4 * 8) = w; } }
    __syncthreads();
    float v[16]; float run = 0.f;
#pragma unroll
    for (int i = 0; i < 16; ++i) { run += A[(part * 16 + i) * 128 + cch]; v[i] = run; }
    vec[V_PSUM + part * 128 + cch] = run;
    __syncthreads();
    float off = 0.f;
#pragma unroll
    for (int pp = 0; pp < 3; ++pp) if (pp < part) off += vec[V_PSUM + pp * 128 + cch];
#pragma unroll
    for (int i = 0; i < 16; ++i) A[(part * 16 + i) * 128 + cch] = v[i] + off;
    __syncthreads();
}

__device__ __forceinline__ void transpose_item(const float* W, int ldw, int K, bf16_t* WT, int k0, int n0, int sn0, LAS float* scr, int lane) {
    float tv[32];
#pragma unroll
    for (int i = 0; i < 32; ++i) { const int kk = 2 * i + (lane >> 5); tv[i] = W[(size_t)(k0 + kk) * ldw + sn0 + (lane & 31)]; }
#pragma unroll
    for (int i = 0; i < 32; ++i) { const int kk = 2 * i + (lane >> 5); scr[kk * 33 + (lane & 31)] = tv[i]; }
    asm volatile("s_waitcnt lgkmcnt(0)" ::: "memory");
    const int c = lane & 7;
#pragma unroll
    for (int j = 0; j < 4; ++j) { const int n = (lane >> 3) + 8 * j; const LAS float* s = scr + (8 * c) * 33 + n;
        u32x4 o; o.x = pk2(s[0 * 33], s[1 * 33]); o.y = pk2(s[2 * 33], s[3 * 33]); o.z = pk2(s[4 * 33], s[5 * 33]); o.w = pk2(s[6 * 33], s[7 * 33]);
        *(u32x4*)(WT + (size_t)(n0 + n) * K + k0 + 8 * c) = o; }
    asm volatile("s_waitcnt lgkmcnt(0)" ::: "memory");
}
#define XB_TMO      128
#define XB_XCNT(j)  (256  + 64 * (j))
#define XB_XSUB(j)  (1280 + 64 * (j))
#define XB_XGEN(j)  (2304 + 64 * (j))
#define XB_TOP      3328
#define XB_TOPGEN   3392
#define XCD_BAR_WORDS 3456
#define XB_SPIN_CAP (1u << 18)
__device__ __forceinline__ unsigned xb_ld(unsigned* p)              { return __hip_atomic_load(p, __ATOMIC_RELAXED, __HIP_MEMORY_SCOPE_AGENT); }
__device__ __forceinline__ unsigned xb_add(unsigned* p, unsigned v) { return __hip_atomic_fetch_add(p, v, __ATOMIC_RELAXED, __HIP_MEMORY_SCOPE_AGENT); }
__device__ __forceinline__ unsigned xb_xcc_id() { return (unsigned)__builtin_amdgcn_s_getreg((3 << 11) | 20) & 0xFu; }
#define XB_SPIN(cond, bar) do { unsigned _sp = 0; while (cond) { __builtin_amdgcn_s_sleep(1); \
    if ((++_sp & 255u) == 0u) { if (xb_ld(&(bar)[XB_TMO])) break; if (_sp > XB_SPIN_CAP) { atomicAdd(&(bar)[XB_TMO], 1u); break; } } } } while (0)
struct XcdBarrier { unsigned* bar; unsigned x; volatile LAS unsigned* st; };
__device__ __forceinline__ XcdBarrier xcd_barrier_post(unsigned* bar, volatile LAS unsigned* st) {
    XcdBarrier b; b.bar = bar; b.x = xb_xcc_id(); b.st = st;
    if (threadIdx.x == 0) (void)xb_add(&bar[XB_XCNT(b.x)], 1u);
    return b;
}
__device__ __forceinline__ void xcd_barrier_complete(unsigned* bar, unsigned x, unsigned& nloc, unsigned& nx) {
    const unsigned G = gridDim.x * gridDim.y * gridDim.z;
    unsigned sum, cnt, mine, sp = 0u;
    for (;;) {
        sum = 0u; cnt = 0u; mine = 0u;
#pragma unroll
        for (unsigned j = 0; j < 16; ++j) { const unsigned c = xb_ld(&bar[XB_XCNT(j)]); sum += c; cnt += (c > 0u) ? 1u : 0u; mine = (j == x) ? c : mine; }
        if (sum == G) break;
        __builtin_amdgcn_s_sleep(1);
        if ((++sp & 255u) == 0u) { if (xb_ld(&bar[XB_TMO])) break; if (sp > XB_SPIN_CAP) { atomicAdd(&bar[XB_TMO], 1u); break; } }
    }
    nloc = mine > 0u ? mine : 1u; nx = cnt > 0u ? cnt : 1u;
}
__device__ __forceinline__ void xcd_barrier(const XcdBarrier& b) {
    asm volatile("s_waitcnt vmcnt(0)" ::: "memory");
    __syncthreads();
    if (threadIdx.x == 0) {
        unsigned* bar = b.bar;
        __builtin_amdgcn_s_waitcnt(0);
        unsigned nloc = b.st[0], nx = b.st[1];
        if (nloc == 0u) { xcd_barrier_complete(bar, b.x, nloc, nx); b.st[0] = nloc; b.st[1] = nx; }
        const unsigned old = xb_add(&bar[XB_XSUB(b.x)], 1u);
        const unsigned gen = old / nloc;
        if (old + 1u == (gen + 1u) * nloc) {
            __builtin_amdgcn_fence(__ATOMIC_RELEASE, "agent");
            asm volatile("s_waitcnt vmcnt(0)" ::: "memory");
            const unsigned og = xb_add(&bar[XB_TOP], 1u);
            const unsigned tg = og / nx;
            if (og + 1u == (tg + 1u) * nx) xb_add(&bar[XB_TOPGEN], 1u);
            else XB_SPIN(xb_ld(&bar[XB_TOPGEN]) == tg, bar);
            __builtin_amdgcn_fence(__ATOMIC_ACQUIRE, "agent");
            xb_add(&bar[XB_XGEN(b.x)], 1u);
            asm volatile("s_waitcnt vmcnt(0)" ::: "memory");
        } else {
            XB_SPIN(xb_ld(&bar[XB_XGEN(b.x)]) == gen, bar);
            __builtin_amdgcn_fence(__ATOMIC_ACQUIRE, "agent");
            asm volatile("s_waitcnt vmcnt(0)" ::: "memory");
        }
    }
    __syncthreads();
}
#ifndef REP_P4
#define REP_P4 1
#endif
#ifndef REP_BAR
#define REP_BAR 1
#endif
#ifndef DBG_STOP
#define DBG_STOP -1
#endif
__device__ __forceinline__ void digest(float* out, const unsigned* w, size_t nwords, bool first, size_t gtid, size_t gthreads) {
    const size_t OUTN = 16777216;
    for (size_t i = gtid; i < OUTN; i += gthreads) { float a = first ? 0.f : out[i];
        for (size_t j = i; j < nwords; j += OUTN) { const unsigned x = w[j]; a += (float)(x & 0xffffu) * (1.f / 65536.f) + (float)(x >> 16) * (1.f / 65536.f); }
        out[i] = a; }
}
#define DG(off, bytes, first) digest(KOUT(), (const unsigned*)(KWS() + (off)), (size_t)(bytes) / 4, first, (size_t)bx * 512 + tid, (size_t)G * 512)
__global__ void __launch_bounds__(512, 2) fwd_kernel(Params p) {
    extern __shared__ __attribute__((aligned(16))) unsigned char lds_raw[];
    LAS unsigned char* lds = (LAS unsigned char*)lds_raw;
    const int tid = threadIdx.x, lane = tid & 63, wave = __builtin_amdgcn_readfirstlane(tid >> 6);
    const int G = gridDim.x, bx = blockIdx.x;
#define stats ((float*)(ws + WS_SMALL + SM_STATS))
#define IG ((float*)(ws + WS_SMALL + SM_IG))
#define LFA ((float*)(ws + WS_SMALL + SM_LFA))
#define CHKL ((float*)(ws + WS_SMALL + SM_CHKL))
#define CHKB ((float*)(ws + WS_SMALL + SM_CHKB))
#define MIN_ ((float*)(ws + WS_SMALL + SM_MIN))
#define CHKN ((float*)(ws + WS_SMALL + SM_CHKN))
#define NIN ((float*)(ws + WS_SMALL + SM_NIN))
#define CHKA ((float*)(ws + WS_SMALL + SM_CHKA))
    LAS float* vec = (LAS float*)(lds + LVEC);
    { volatile LAS unsigned* st0 = (volatile LAS unsigned*)(lds + LDS_BYTES - 16); if (tid < 4) st0[tid] = 0u; }
    __syncthreads();
    const XcdBarrier xbar = xcd_barrier_post((unsigned*)(KWS() + WS_SMALL + SM_BAR), (volatile LAS unsigned*)(lds + LDS_BYTES - 16));
#define GSYNC() xcd_barrier(xbar)

    {
        unsigned char* const ws = KWS();
        const int gw = bx * 8 + wave, NGW = G * 8;
        LAS float* scr = (LAS float*)(lds + wave * 8448);
        { const float* W = KIN(10); bf16_t* WT = (bf16_t*)(ws + WS_WIN);
          for (int it = gw; it < 16 * 128; it += NGW) { const int kb = it >> 7, nb = it & 127, n0 = 32 * nb; transpose_item(W, DIN, 1024, WT, 64 * kb, n0, n0 >= 2048 ? n0 + 8 : n0, scr, lane); } }
        __syncthreads();
        LAS float* wg = (LAS float*)(lds + 69632);
        { const float* win = KIN(10); float wv[16];
#pragma unroll
          for (int i = 0; i < 16; ++i) { const int idx = tid + i * 512; wv[i] = win[(size_t)(idx >> 3) * DIN + 2048 + (idx & 7)]; }
#pragma unroll
          for (int i = 0; i < 16; ++i) { const int idx = tid + i * 512; wg[(idx & 7) * 1024 + (idx >> 3)] = wv[i]; } }
        __syncthreads();
        bf16_t* XN = (bf16_t*)(ws + WS_XN);
        const float* lg = KIN(8); const float* lb = KIN(9);
        const float* xpr = KIN(0); const float* xsm = KIN(1); const float* meta = KIN(7);
        float bi_i = 0.f, bi_f = 0.f;
        if (lane < 4) { bi_i = KIN(11)[2048 + lane]; bi_f = KIN(11)[2052 + lane] + KIN(12)[lane]; }
        f32x4 nv[4];
        if (gw < MR) { const f32x4* x0 = (const f32x4*)xrow_ptr(xpr, xsm, meta, gw) + lane;
#pragma unroll
            for (int j = 0; j < 4; ++j) nv[j] = x0[64 * j]; }
        for (int r = gw; r < MP; r += NGW) {
            unsigned long long* o8 = (unsigned long long*)(XN + (size_t)r * DM) + lane;
            f32x4 v[4]; float s = 0.f;
#pragma unroll
            for (int j = 0; j < 4; ++j) v[j] = nv[j];
            if (r + NGW < MR) { const f32x4* xn = (const f32x4*)xrow_ptr(xpr, xsm, meta, r + NGW) + lane;
#pragma unroll
                for (int j = 0; j < 4; ++j) nv[j] = xn[64 * j]; }
            if (r >= MR) {
#pragma unroll
                for (int j = 0; j < 4; ++j) o8[64 * j] = 0ull;
                continue; }
#pragma unroll
            for (int j = 0; j < 4; ++j) s += (v[j].x + v[j].y) + (v[j].z + v[j].w);
            const float mean = wave_sum(s) * (1.f / DM); float s2 = 0.f;
#pragma unroll
            for (int j = 0; j < 4; ++j) { v[j] = v[j] - mean; s2 += (v[j].x * v[j].x + v[j].y * v[j].y) + (v[j].z * v[j].z + v[j].w * v[j].w); }
            const float rstd = 1.f / sqrtf(wave_sum(s2) * (1.f / DM) + LN_EPS);
            float gd[8];
#pragma unroll
            for (int g = 0; g < 8; ++g) gd[g] = 0.f;
#pragma unroll
            for (int j = 0; j < 4; ++j) {
                const f32x4 gg = *((const f32x4*)lg + lane + 64 * j), bb = *((const f32x4*)lb + lane + 64 * j);
                v[j] = v[j] * rstd * gg + bb;
                o8[64 * j] = (unsigned long long)pk2(v[j].x, v[j].y) | ((unsigned long long)pk2(v[j].z, v[j].w) << 32);
#pragma unroll
                for (int g = 0; g < 8; ++g) { const f32x4 w = *((const LAS f32x4*)(wg + g * 1024) + lane + 64 * j); gd[g] += (v[j].x * w.x + v[j].y * w.y) + (v[j].z * w.z + v[j].w * w.w); }
            }
#pragma unroll
            for (int g = 0; g < 8; ++g) gd[g] = wave_sum(gd[g]);
            if (lane == 0) { stats[2 * r] = mean; stats[2 * r + 1] = rstd; }
            if (lane < 4) {
                float gi = gd[0], gf = gd[4];
                if (lane == 1) { gi = gd[1]; gf = gd[5]; } else if (lane == 2) { gi = gd[2]; gf = gd[6]; } else if (lane == 3) { gi = gd[3]; gf = gd[7]; }
                IG[r * 4 + lane] = gi + bi_i;
                const float x = gf + bi_f;
                LFA[r * 4 + lane] = (x < 0.f) ? x - log1pf(expf(x)) : -log1pf(expf(-x));
            }
        }
    }
    GSYNC();
    if (DBG_STOP == 0) { DG(0, 26 * MiB + 512 * 1024, true); DG(WS_XN, SZ_R1024, false); DG(WS_SMALL + SM_STATS, (size_t)MR * 8, false); DG(WS_SMALL + SM_IG, (size_t)MR * 16, false); DG(WS_SMALL + SM_LFA, (size_t)MR * 16, false); return; }

    {
        unsigned char* const ws = KWS();
        pg8::Gemm g{(const bf16_t*)(ws + WS_XN), (const bf16_t*)(ws + WS_WIN), MP, 4096, 1024}; pg8::StaticOrder S; S.init(MP, 4096, G, bx);
        pg8::EpiIn E{ws, KIN(11)};
        pg8::gemm_phase<pg8::EpiIn, pg8::StaticOrder, true, true>(lds, g, S, E);
        {
            const int nwg = (MP / 256) * 16, rem = nwg % G, nfree = rem ? G - rem : G, fb = rem ? bx - rem : bx;
            if (fb >= 0) {
                LAS float* scr = (LAS float*)(lds + wave * 8448);
                constexpr int I_OUT = 16 * 32, I_UP = 16 * 176, I_DN = 44 * 32;
                for (int it = fb * 8 + wave; it < I_OUT + I_UP + I_DN; it += nfree * 8) {
                    int r = it;
                    if (r < I_OUT) { transpose_item(KIN(16), 1024, 1024, (bf16_t*)(ws + WS_WOUT), 64 * (r / 32), 32 * (r % 32), 32 * (r % 32), scr, lane); continue; } r -= I_OUT;
                    if (r < I_UP) { transpose_item(KIN(20), 2 * DFF, 1024, (bf16_t*)(ws + WS_WUP), 64 * (r / 176), 32 * (r % 176), 32 * (r % 176), scr, lane); continue; } r -= I_UP;
                    transpose_item(KIN(24), 1024, DFF, (bf16_t*)(ws + WS_WDN), 64 * (r / 32), 32 * (r % 32), 32 * (r % 32), scr, lane);
                }
            }
        }
    }
    GSYNC();
    if (DBG_STOP == 1) { DG(WS_QAB, SZ_R1024 + 5 * SZ_R512 + SZ_R1024, true); return; }

    { unsigned char* const ws = KWS(); const float* lbl = KIN(15);
    for (int item = bx; item < 2 * NSLOT; item += G) {
        const int type = item / NSLOT, j = item - type * NSLOT, b = j / 132, rem = j - b * 132, h = rem / NCH, c = rem - h * NCH;
        const int p0 = c ? NMETA + (c - 1) * 64 : 0, len = c ? 64 : NMETA, r0 = b * TP + p0;
        u32x4 rk[2], rv[2]; f32x4 fbv[4];
        chunk_ld(rv, (const bf16_t*)(ws + (type ? WS_IB : WS_VA)) + (size_t)r0 * 512 + h * 128, 512, len, tid);
        if (type == 0) chunk_ld(rk, (const bf16_t*)(ws + WS_KA) + (size_t)r0 * 512 + h * 128, 512, len, tid);
        else fb_ld(fbv, (const float*)(ws + WS_FB) + (size_t)r0 * 512 + h * 128, len, tid);
        __syncthreads();
        chunk_st(lds + LV, rv, tid);
        if (type == 0) {
            if (wave == 0) {
                const bool valid = lane < len;
                const float ig = valid ? IG[(r0 + lane) * 4 + h] : 0.f; float bc = valid ? LFA[(r0 + lane) * 4 + h] : 0.f;
#pragma unroll
                for (int o = 1; o < 64; o <<= 1) { const float t = __shfl_up(bc, o); if (lane >= o) bc += t; }
                const float a = valid ? ig - bc : -INFINITY; float mx = a;
#pragma unroll
                for (int o = 1; o < 64; o <<= 1) mx = fmaxf(mx, __shfl_xor(mx, o));
                const float bT = __shfl(bc, len - 1);
                vec[V_WT + lane] = valid ? __expf(a - mx) : 0.f;
                if (lane == 0) { CHKL[j] = mx; CHKB[j] = bT; }
            }
            __syncthreads();
#pragma unroll
            for (int i = 0; i < 2; ++i) { const int q = tid + i * 512, s = q >> 4, cc = q & 15;
                u32x4 v = rk[i];
                if (s < len) { const float w = vec[V_WT + s];
                    v.x = pk2(bflo(v.x) * w, bfhi(v.x) * w); v.y = pk2(bflo(v.y) * w, bfhi(v.y) * w); v.z = pk2(bflo(v.z) * w, bfhi(v.z) * w); v.w = pk2(bflo(v.w) * w, bfhi(v.w) * w); }
                *(LAS u32x4*)(lds + LK + s * RSTR + cc * 16) = v; }
            __syncthreads();
            if (tid < 128) { float s = 0.f;
#pragma unroll 8
                for (int q = 0; q < 64; ++q) s += bf2f(*(const LAS bf16_t*)(lds + LK + q * RSTR + tid * 2));
                CHKN[j * 128 + tid] = s; }
        } else {
            hgrn_prep(lds, fbv, lbl, h, len, tid);
            LAS float* A = (LAS float*)(lds + LA);
            const int cch = tid & 127, part = tid >> 7;
            const float aT = A[(len - 1) * 128 + cch];
            if (tid < 128) CHKA[j * 128 + tid] = aT;
#pragma unroll 4
            for (int i = 0; i < 16; ++i) { const int s = part + 4 * i; LAS bf16_t* kp = (LAS bf16_t*)(lds + LK + s * RSTR + cch * 2);
                *kp = (bf16_t)f2bf(__expf(aT - A[s * 128 + cch]) * bf2f(*kp)); }
            __syncthreads();
        }
        {
            bf16_t* dst = (bf16_t*)(ws + (type ? WS_CSTH : WS_CSTM)) + (size_t)j * 16384;
            const int e0 = 16 * wave;
            const bf16x8 a0 = trfrag(lds + LV, RSTR, 0, e0, lane), a1 = trfrag(lds + LV, RSTR, 32, e0, lane);
#pragma unroll 2
            for (int dt = 0; dt < 8; ++dt) {
                f32x4 acc = (f32x4){0.f, 0.f, 0.f, 0.f};
                const bf16x8 b0 = trfrag(lds + LK, RSTR, 0, 16 * dt, lane), b1 = trfrag(lds + LK, RSTR, 32, 16 * dt, lane);
                acc = __builtin_amdgcn_mfma_f32_16x16x32_bf16(a0, b0, acc, 0, 0, 0);
                acc = __builtin_amdgcn_mfma_f32_16x16x32_bf16(a1, b1, acc, 0, 0, 0);
                u32x2 w; w.x = pk2(acc[0], acc[1]); w.y = pk2(acc[2], acc[3]);
                *(u32x2*)(dst + (16 * dt + (lane & 15)) * 128 + e0 + 4 * (lane >> 4)) = w;
            }
        }
    } }
    GSYNC();
    if (DBG_STOP == 2) { DG(WS_CSTM, SZ_CST, true); DG(WS_CSTH, SZ_CST, false); DG(WS_SMALL + SM_CHKL, NSLOT * 4, false); DG(WS_SMALL + SM_CHKB, NSLOT * 4, false); DG(WS_SMALL + SM_CHKN, NSLOT * 512, false); DG(WS_SMALL + SM_CHKA, NSLOT * 512, false); return; }

    { unsigned char* const ws = KWS(); float* const outp = KOUT();
    for (int unit = bx; unit < 2 * NB * 4 * 4; unit += G) {
        const int type = unit >> 7, sq = (unit >> 2) & 31, quarter = unit & 3;
        const int eo = quarter * 4096 + tid * 8, d = eo >> 7;
        bf16_t* base = (bf16_t*)(ws + (type ? WS_CSTH : WS_CSTM)) + (size_t)sq * NCH * 16384 + eo;
        const bool nthr = (type == 0 && quarter == 0 && tid < 128);
        __syncthreads();
        if (type == 0 && tid < NCH) { vec[tid] = CHKL[sq * NCH + tid]; vec[64 + tid] = CHKB[sq * NCH + tid]; }
        __syncthreads();
        float carry[8];
#pragma unroll
        for (int i = 0; i < 8; ++i) carry[i] = 0.f;
        float m_in = 0.f, ncar = 0.f;
#pragma unroll 1
        for (int cg = 0; cg < NCH; cg += 11) {
            u32x4 uu[11]; float aux[11];
#pragma unroll
            for (int k = 0; k < 11; ++k) uu[k] = *(const u32x4*)(base + (size_t)(cg + k) * 16384);
#pragma unroll
            for (int k = 0; k < 11; ++k) aux[k] = (type == 0) ? (nthr ? CHKN[(sq * NCH + cg + k) * 128 + tid] : 0.f) : CHKA[(sq * NCH + cg + k) * 128 + d];
#pragma unroll
            for (int k = 0; k < 11; ++k) {
                const int c = cg + k, sidx = sq * NCH + c;
                u32x4 w; w.x = pk2(carry[0], carry[1]); w.y = pk2(carry[2], carry[3]); w.z = pk2(carry[4], carry[5]); w.w = pk2(carry[6], carry[7]);
                *(u32x4*)(base + (size_t)c * 16384) = w;
                float al, be;
                if (type == 0) {
                    const float L = vec[c], bT = vec[64 + c]; const float mn = bT + fmaxf(m_in, L);
                    al = __expf(bT + m_in - mn); be = __expf(bT + L - mn);
                    if (quarter == 0 && tid == 0) MIN_[sidx] = m_in;
                    if (nthr) { NIN[sidx * 128 + tid] = ncar; ncar = al * ncar + be * aux[k]; }
                    m_in = mn;
                } else { al = __expf(aux[k]); be = 1.f; }
                const u32x4 u4 = uu[k];
                carry[0] = al * carry[0] + be * bflo(u4.x); carry[1] = al * carry[1] + be * bfhi(u4.x);
                carry[2] = al * carry[2] + be * bflo(u4.y); carry[3] = al * carry[3] + be * bfhi(u4.y);
                carry[4] = al * carry[4] + be * bflo(u4.z); carry[5] = al * carry[5] + be * bfhi(u4.z);
                carry[6] = al * carry[6] + be * bflo(u4.w); carry[7] = al * carry[7] + be * bfhi(u4.w);
            }
        }
        float* o = outp + (type ? O_SP : O_CP) + (size_t)sq * 16384 + eo;
        *(f32x4*)o = (f32x4){carry[0], carry[1], carry[2], carry[3]}; *(f32x4*)(o + 4) = (f32x4){carry[4], carry[5], carry[6], carry[7]};
        if (nthr) outp[O_NP + sq * 128 + tid] = ncar;
        if (type == 0 && quarter == 0 && tid == 0) outp[O_MPR + sq] = m_in;
    } }
    GSYNC();
    if (DBG_STOP == 3) { DG(WS_CSTM, SZ_CST, true); DG(WS_CSTH, SZ_CST, false); DG(WS_SMALL + SM_MIN, NSLOT * 4, false); DG(WS_SMALL + SM_NIN, NSLOT * 512, false); return; }

    { unsigned char* const ws = KWS(); float* const outp = KOUT(); const float* lbl = KIN(15);
      const float* stC = KIN(2); const float* stN = KIN(3); const float* stM = KIN(4); const float* stS = KIN(5); const float* gna = KIN(13); const float* gnb = KIN(14);
#define P4_DECODE(it_) do { const int it__ = (it_); n_sidx = 0; n_sb = 0; n_sample = false; \
        if (it__ < 2 * NSLOT) { n_type = it__ / NSLOT; const int j = it__ - n_type * NSLOT, b = j / 132, rem = j - b * 132; n_h = rem / NCH; const int c = rem - n_h * NCH; \
            n_len = c ? 64 : NMETA; n_r0 = b * TP + (c ? NMETA + (c - 1) * 64 : 0); n_sidx = j; } \
        else { const int j = it__ - 2 * NSLOT; n_type = j >> 9; const int rem = j & 511; n_sb = rem >> 2; n_h = rem & 3; n_len = DS; n_r0 = RP + n_sb * DS; n_sample = true; } } while (0)
#define P4_ISSUE() do { \
        chunk_ld(rq, (const bf16_t*)(ws + WS_QAB) + (size_t)n_r0 * 1024 + n_type * 512 + n_h * 128, 1024, n_len, tid); \
        chunk_ld(rv, (const bf16_t*)(ws + (n_type ? WS_IB : WS_VA)) + (size_t)n_r0 * 512 + n_h * 128, 512, n_len, tid); \
        if (n_type == 0) { u32x4 rk_[2]; chunk_ld(rk_, (const bf16_t*)(ws + WS_KA) + (size_t)n_r0 * 512 + n_h * 128, 512, n_len, tid); fbv[0] = __builtin_bit_cast(f32x4, rk_[0]); fbv[1] = __builtin_bit_cast(f32x4, rk_[1]); } \
        else fb_ld(fbv, (const float*)(ws + WS_FB) + (size_t)n_r0 * 512 + n_h * 128, n_len, tid); \
        if (!n_sample) { const bf16_t* cs = (const bf16_t*)(ws + (n_type ? WS_CSTH : WS_CSTM)) + (size_t)n_sidx * 16384; \
            _Pragma("unroll") for (int i = 0; i < 4; ++i) { const int q = tid + i * 512, d = q >> 4, cc = q & 15; cst[i] = *(const f32x4*)(cs + d * 128 + cc * 8); } } \
        if (n_type == 0) { \
            if (wave == 0) { const bool valid_ = lane < n_len; pg_a = valid_ ? IG[(n_r0 + lane) * 4 + n_h] : 0.f; pg_b = valid_ ? LFA[(n_r0 + lane) * 4 + n_h] : 0.f; \
                pg_m = n_sample ? stM[n_sb * 4 + n_h] : MIN_[n_sidx]; } \
            else if (wave == 2 || wave == 3) { const int d_ = tid - 128; pg_a = n_sample ? stN[(n_sb * 4 + n_h) * 128 + d_] : NIN[n_sidx * 128 + d_]; } } \
        } while (0)
    u32x4 rq[2], rv[2]; f32x4 cst[4]; f32x4 fbv[4];
    float pg_a = 0.f, pg_b = 0.f, pg_m = 0.f;
    __syncthreads();
    { LAS float* gl = (LAS float*)(lds + LGN); gl[tid] = gna[tid]; gl[512 + tid] = gnb[tid]; }
    int n_type = 0, n_h = 0, n_len = 0, n_r0 = 0, n_sidx = 0, n_sb = 0; bool n_sample = false;
    constexpr int P4N = 2 * NSLOT + 1024;
    if (bx < P4N) { P4_DECODE(bx); P4_ISSUE(); }
    for (int item = bx; item < P4N; item += G) {
        const int type = n_type, h = n_h, len = n_len, r0 = n_r0, sidx = n_sidx, sb = n_sb; const bool sample = n_sample;
        const float* Csrc = (type ? stS : stC) + (size_t)(sb * 4 + h) * 16384;
        __syncthreads();
        u32x4 rg[2]; chunk_ld(rg, (const bf16_t*)(ws + (type ? WS_GB : WS_OA)) + (size_t)r0 * 512 + h * 128, 512, len, tid);
        chunk_st(lds + LQ, rq, tid); chunk_st(lds + LV, rv, tid);
        if (type == 0) { u32x4 rk_[2]; rk_[0] = __builtin_bit_cast(u32x4, fbv[0]); rk_[1] = __builtin_bit_cast(u32x4, fbv[1]); chunk_st(lds + LK, rk_, tid); }
        if (!sample) {
#pragma unroll
            for (int i = 0; i < 4; ++i) { const int q = tid + i * 512, d = q >> 4, cc = q & 15; *(LAS f32x4*)(lds + LC + d * RSTR + cc * 16) = cst[i]; }
        } else {
            f32x4 sst[8];
#pragma unroll
            for (int i = 0; i < 8; ++i) { const int q = tid + i * 512, d = q >> 5, c4 = q & 31; sst[i] = *(const f32x4*)(Csrc + d * 128 + c4 * 4); }
#pragma unroll
            for (int i = 0; i < 8; ++i) { const int q = tid + i * 512, d = q >> 5, c4 = q & 31; const f32x4 v = sst[i];
                u32x2 w; w.x = pk2(v.x, v.y); w.y = pk2(v.z, v.w); *(LAS u32x2*)(lds + LC + d * RSTR + c4 * 8) = w; }
        }
        if (tid < 64) { vec[V_DENI + tid] = 0.f; vec[V_SSQ + tid] = 0.f; }
        if (type == 0) {
            if (wave == 0) {
                const bool valid = lane < len;
                const float m_in = pg_m;
                const float ig = pg_a; float bc = pg_b;
#pragma unroll
                for (int o = 1; o < 64; o <<= 1) { const float t = __shfl_up(bc, o); if (lane >= o) bc += t; }
                const float a = valid ? ig - bc : -INFINITY; float mx = a;
#pragma unroll
                for (int o = 1; o < 64; o <<= 1) { const float t = __shfl_up(mx, o); if (lane >= o) mx = fmaxf(mx, t); }
                const float mt = bc + fmaxf(m_in, mx);
                vec[V_BM + lane] = bc - mt; vec[V_AV + lane] = a; vec[V_DEC + lane] = __expf(bc + m_in - mt); vec[V_EM + lane] = __expf(-mt);
                const float bmT = __shfl(bc - mt, len - 1);
                vec[V_WT + lane] = valid ? __expf(bmT + a) : 0.f;
                if (sample && lane == len - 1) outp[O_MS + sb * 4 + h] = mt;
            } else if (wave == 2 || wave == 3) {
                const int d = tid - 128;
                vec[V_NIN + d] = pg_a;
            }
            __syncthreads();
        } else {
            hgrn_prep(lds, fbv, lbl, h, len, tid);
            LAS float* A = (LAS float*)(lds + LA);
            const int cch = tid & 127, part = tid >> 7;
#pragma unroll 4
            for (int i = 0; i < 16; ++i) { const int s = part + 4 * i; const float a = A[s * 128 + cch];
                LAS bf16_t* kp = (LAS bf16_t*)(lds + LK + s * RSTR + cch * 2); *kp = (bf16_t)f2bf(__expf(-a) * bf2f(*kp));
                LAS bf16_t* qp = (LAS bf16_t*)(lds + LQ + s * RSTR + cch * 2); *qp = (bf16_t)f2bf(__expf(a) * bf2f(*qp)); }
            __syncthreads();
        }
        if (type == 0) {
            const int t = tid >> 3, part = tid & 7; float s = 0.f;
            const LAS bf16_t* qp = (const LAS bf16_t*)(lds + LQ + t * RSTR) + part * 16;
#pragma unroll
            for (int i = 0; i < 16; ++i) s += bf2f(qp[i]) * vec[V_NIN + part * 16 + i];
            s += __shfl_xor(s, 1); s += __shfl_xor(s, 2); s += __shfl_xor(s, 4);
            if (part == 0) vec[V_DENQ + t] = s * vec[V_DEC + t];
        }
        chunk_st(lds + LG, rg, tid);
        {
            const int t0 = 16 * (wave & 3), tt = t0 + (lane & 15);
            bf16x8 qf[4];
#pragma unroll
            for (int k = 0; k < 4; ++k) qf[k] = rowfrag(lds + LQ, RSTR, t0, 32 * k, lane);
            const float bmt = (type == 0) ? vec[V_BM + tt] : 0.f;
            float rsum = 0.f;
#pragma unroll
            for (int si = 0; si < 2; ++si) {
                const int s0 = 16 * ((wave >> 2) * 2 + si);
                f32x4 acc = (f32x4){0.f, 0.f, 0.f, 0.f};
#pragma unroll
                for (int k = 0; k < 4; ++k) acc = __builtin_amdgcn_mfma_f32_16x16x32_bf16(rowfrag(lds + LK, RSTR, s0, 32 * k, lane), qf[k], acc, 0, 0, 0);
                float sw[4];
#pragma unroll
                for (int jj = 0; jj < 4; ++jj) { const int s = s0 + 4 * (lane >> 4) + jj; const bool ok = (s <= tt) && (s < len);
                    float w = 1.f; if (type == 0) w = __expf(bmt + (ok ? vec[V_AV + s] : 0.f));
                    sw[jj] = ok ? acc[jj] * w : 0.f; rsum += sw[jj]; }
                u32x2 w2; w2.x = pk2(sw[0], sw[1]); w2.y = pk2(sw[2], sw[3]);
                *(LAS u32x2*)(lds + LSW + tt * SWSTR + (s0 + 4 * (lane >> 4)) * 2) = w2;
            }
            if (type == 0) { rsum += __shfl_xor(rsum, 16); rsum += __shfl_xor(rsum, 32); if (lane < 16) atomicAdd((float*)(vec + V_DENI + tt), rsum); }
        }
        __syncthreads();
        { const int nxi = item + G; if (nxi < P4N) { P4_DECODE(nxi); P4_ISSUE(); } }
        {
            const int t0 = 16 * (wave & 3), tt = t0 + (lane & 15);
            bf16x8 qf[4], sf[2];
#pragma unroll
            for (int k = 0; k < 4; ++k) qf[k] = rowfrag(lds + LQ, RSTR, t0, 32 * k, lane);
#pragma unroll
            for (int k = 0; k < 2; ++k) sf[k] = rowfrag(lds + LSW, SWSTR, t0, 32 * k, lane);
            float dect = 1.f, rden = 1.f;
            if (type == 0) { dect = vec[V_DEC + tt]; const float den = vec[V_DENQ + tt] + vec[V_DENI + tt]; rden = frcp(fmaxf(fabsf(den), vec[V_EM + tt])); }
            f32x4 hv[4]; float ss = 0.f;
#pragma unroll
            for (int ei = 0; ei < 4; ++ei) {
                const int e0 = 16 * ((wave >> 2) * 4 + ei);
                f32x4 a1 = (f32x4){0.f, 0.f, 0.f, 0.f}, a2 = a1;
#pragma unroll
                for (int k = 0; k < 4; ++k) a1 = __builtin_amdgcn_mfma_f32_16x16x32_bf16(trfrag(lds + LC, RSTR, 32 * k, e0, lane), qf[k], a1, 0, 0, 0);
#pragma unroll
                for (int k = 0; k < 2; ++k) a2 = __builtin_amdgcn_mfma_f32_16x16x32_bf16(trfrag(lds + LV, RSTR, 32 * k, e0, lane), sf[k], a2, 0, 0, 0);
                hv[ei] = (a1 * dect + a2) * rden;
                ss += (hv[ei][0] * hv[ei][0] + hv[ei][1] * hv[ei][1]) + (hv[ei][2] * hv[ei][2] + hv[ei][3] * hv[ei][3]);
            }
            ss += __shfl_xor(ss, 16); ss += __shfl_xor(ss, 32);
            if (lane < 16) atomicAdd((float*)(vec + V_SSQ + tt), ss);
            __syncthreads();
            const float rs = rsqrtf(vec[V_SSQ + tt] * (1.0f / 128.0f) + RMS_EPS);
            if (tt < len) {
                const LAS float* gn = (const LAS float*)(lds + LGN) + type * 512 + h * 128;
                bf16_t* dst = (bf16_t*)(ws + WS_QAB) + (size_t)(r0 + tt) * 1024 + type * 512 + h * 128;
#pragma unroll
                for (int ei = 0; ei < 4; ++ei) {
                    const int e = 16 * ((wave >> 2) * 4 + ei) + 4 * (lane >> 4);
                    const u32x2 gt = *(const LAS u32x2*)(lds + LG + tt * RSTR + e * 2); const f32x4 g4 = *(const LAS f32x4*)(gn + e);
                    const f32x4 o = hv[ei] * rs * g4 * (f32x4){bflo(gt.x), bfhi(gt.x), bflo(gt.y), bfhi(gt.y)};
                    u32x2 w; w.x = pk2(o[0], o[1]); w.y = pk2(o[2], o[3]); *(u32x2*)(dst + e) = w;
                }
            }
        }
        if (sample) {
            const int e4 = tid & 31, dg = tid >> 5;
            LAS float* A = (LAS float*)(lds + LA);
            f32x4 vv[DS];
#pragma unroll
            for (int s = 0; s < DS; ++s) { const u32x2 t = *(const LAS u32x2*)(lds + LV + s * RSTR + e4 * 8); const float w = (type == 0) ? vec[V_WT + s] : 1.f;
                vv[s] = (f32x4){bflo(t.x), bfhi(t.x), bflo(t.y), bfhi(t.y)} * w; }
            const float decT = (type == 0) ? vec[V_DEC + DS - 1] : 1.f;
            float* od = outp + (type ? O_SS : O_CS) + (size_t)(sb * 4 + h) * 16384;
#pragma unroll 2
            for (int i = 0; i < 8; ++i) { const int d = dg + 16 * i;
                const float rsc = (type == 0) ? decT : __expf(A[(DS - 1) * 128 + d]); const float ksc = (type == 0) ? 1.f : rsc;
                f32x4 o = *(const f32x4*)(Csrc + d * 128 + e4 * 4) * rsc;
#pragma unroll
                for (int s = 0; s < DS; ++s) o += vv[s] * (ksc * bf2f(*(const LAS bf16_t*)(lds + LK + s * RSTR + d * 2)));
                *(f32x4*)(od + d * 128 + e4 * 4) = o; }
            if (type == 0 && tid < 128) { float n = decT * vec[V_NIN + tid];
#pragma unroll
                for (int s = 0; s < DS; ++s) n += vec[V_WT + s] * bf2f(*(const LAS bf16_t*)(lds + LK + s * RSTR + tid * 2));
                outp[O_NS + (sb * 4 + h) * 128 + tid] = n; }
        }
    } }
    GSYNC();
    if (DBG_STOP == 4) { DG(WS_QAB, SZ_R1024, true); return; }

    {
        unsigned char* const ws = KWS();
        pg8::Gemm g{(const bf16_t*)(ws + WS_QAB), (const bf16_t*)(ws + WS_WOUT), MP, 1024, 1024}; pg8::TailSplitOrder S; S.init(MP, 1024, G, bx, 1024, 8);
        pg8::EpiZ1 E{KIN(0), KIN(1), KIN(7), KIN(8), KIN(9), KIN(17), stats, (float*)(ws + WS_Z1), KOUT(), S.tail_row0()};
        pg8::gemm_phase<pg8::EpiZ1, pg8::TailSplitOrder, true, true>(lds, g, S, E);
    }
    GSYNC();
    if (DBG_STOP == 5) { DG(WS_Z1, 2 * SZ_R1024, true); return; }
    {
        unsigned char* const ws = KWS();
        const int gw = bx * 8 + wave, NGW = G * 8;
        const float* z1 = (const float*)(ws + WS_Z1); bf16_t* X1B = (bf16_t*)(ws + WS_X1B);
        pg8::TailSplitOrder S5; S5.init(MP, 1024, G, bx, 1024, 8); const int tr0 = S5.tail_row0(); const float* ztail = KOUT();
        const float* lg = KIN(18); const float* lb = KIN(19);
#define Z1ROW(r_) ((const f32x4*)((r_) >= tr0 ? ztail + (size_t)((r_) - tr0) * DM : z1 + (size_t)(r_) * DM) + lane)
        f32x4 nv[4];
        if (gw < MR) { const f32x4* xr = Z1ROW(gw);
#pragma unroll
            for (int j = 0; j < 4; ++j) nv[j] = xr[64 * j]; }
        for (int r = gw; r < MP; r += NGW) {
            unsigned long long* o8 = (unsigned long long*)(X1B + (size_t)r * DM) + lane;
            f32x4 v[4]; float s = 0.f;
#pragma unroll
            for (int j = 0; j < 4; ++j) v[j] = nv[j];
            if (r + NGW < MR) { const f32x4* xn = Z1ROW(r + NGW);
#pragma unroll
                for (int j = 0; j < 4; ++j) nv[j] = xn[64 * j]; }
            if (r >= MR) {
#pragma unroll
                for (int j = 0; j < 4; ++j) o8[64 * j] = 0ull;
                continue; }
            const f32x4* xr = Z1ROW(r);
            if (r >= tr0) for (int pc = 1; pc < 8; ++pc) {
#pragma unroll
                for (int j = 0; j < 4; ++j) v[j] += xr[pc * (pg8::PART_STRIDE / 4) + 64 * j]; }
#pragma unroll
            for (int j = 0; j < 4; ++j) s += (v[j].x + v[j].y) + (v[j].z + v[j].w);
            const float mean = wave_sum(s) * (1.f / DM); float s2 = 0.f;
#pragma unroll
            for (int j = 0; j < 4; ++j) { v[j] = v[j] - mean; s2 += (v[j].x * v[j].x + v[j].y * v[j].y) + (v[j].z * v[j].z + v[j].w * v[j].w); }
            const float rstd = 1.f / sqrtf(wave_sum(s2) * (1.f / DM) + LN_EPS);
#pragma unroll
            for (int j = 0; j < 4; ++j) {
                const f32x4 gg = *((const f32x4*)lg + lane + 64 * j), bb = *((const f32x4*)lb + lane + 64 * j);
                v[j] = v[j] * rstd * gg + bb;
                o8[64 * j] = (unsigned long long)pk2(v[j].x, v[j].y) | ((unsigned long long)pk2(v[j].z, v[j].w) << 32);
            }
        }
    }
    GSYNC();
    if (DBG_STOP == 6) { DG(WS_X1B, SZ_R1024, true); return; }
    {
        unsigned char* const ws = KWS();
        pg8::Gemm g{(const bf16_t*)(ws + WS_X1B), (const bf16_t*)(ws + WS_WUP), MP, DFF, 1024}; pg8::StaticOrder S; S.init(MP, DFF, G, bx);
        pg8::EpiU E{(bf16_t*)(ws + WS_U), KIN(21), KOUT()};
        pg8::gemm_phase<pg8::EpiU, pg8::StaticOrder, true, true>(lds, g, S, E);
    }
    GSYNC();
    if (DBG_STOP == 7) { DG(WS_U, SZ_U, true); return; }
    {
        unsigned char* const ws = KWS();
        pg8::Gemm g{(const bf16_t*)(ws + WS_X1B), (const bf16_t*)(ws + WS_WUP) + (size_t)DFF * 1024, MP, DFF, 1024}; pg8::StaticOrder S; S.init(MP, DFF, G, bx);
        pg8::EpiAct E{(const bf16_t*)(ws + WS_U), (bf16_t*)(ws + WS_ACT), KIN(21) + DFF, KIN(22), KIN(23), KIN(6)};
        pg8::gemm_phase<pg8::EpiAct, pg8::StaticOrder, true, true>(lds, g, S, E);
    }
    GSYNC();
    if (DBG_STOP == 8) { DG(WS_ACT, SZ_U, true); return; }
    {
        unsigned char* const ws = KWS();
        pg8::Gemm g{(const bf16_t*)(ws + WS_ACT), (const bf16_t*)(ws + WS_WDN), MP, 1024, DFF}; pg8::TailSplitOrder S; S.init(MP, 1024, G, bx, DFF, 11);
        pg8::EpiZ2 E{(const bf16_t*)(ws + WS_X1B), KIN(25), KOUT(), (float*)(ws + WS_U), S.tail_row0()};
        pg8::gemm_phase<pg8::EpiZ2, pg8::TailSplitOrder, true, true>(lds, g, S, E);
    }
    GSYNC();
    {
        const int gw = bx * 8 + wave, NGW = G * 8;
        const float* lg = KIN(26); const float* lb = KIN(27); float* const outp = KOUT();
        pg8::TailSplitOrder S7; S7.init(MP, 1024, G, bx, DFF, 11); const int ty0 = S7.split_mode ? S7.tail_row0() - 128 : (1 << 30);
        const float* part = (const float*)(KWS() + WS_U);
#define Z2ROW(r_) ((const f32x4*)((r_) >= ty0 ? part + (size_t)((r_) - ty0) * DM : outp + (size_t)(r_) * DM) + lane)
        f32x4 nv[4];
        if (gw < NB * SEQ + RS) { const f32x4* x0 = Z2ROW(gw);
#pragma unroll
            for (int j = 0; j < 4; ++j) nv[j] = x0[64 * j]; }
        for (int r = gw; r < NB * SEQ + RS; r += NGW) {
            f32x4* xr = (f32x4*)(outp + (size_t)r * DM) + lane;
            f32x4 v[4]; float s = 0.f;
#pragma unroll
            for (int j = 0; j < 4; ++j) v[j] = nv[j];
            if (r + NGW < NB * SEQ + RS) { const f32x4* xn = Z2ROW(r + NGW);
#pragma unroll
                for (int j = 0; j < 4; ++j) nv[j] = xn[64 * j]; }
            if (r >= ty0) {
                const f32x4* pr = Z2ROW(r);
                for (int pc = 1; pc < 11; ++pc) {
#pragma unroll
                    for (int j = 0; j < 4; ++j) v[j] += pr[pc * (pg8::PART_STRIDE / 4) + 64 * j]; }
            }
#pragma unroll
            for (int j = 0; j < 4; ++j) s += (v[j].x + v[j].y) + (v[j].z + v[j].w);
            const float mean = wave_sum(s) * (1.f / DM); float s2 = 0.f;
#pragma unroll
            for (int j = 0; j < 4; ++j) { v[j] = v[j] - mean; s2 += (v[j].x * v[j].x + v[j].y * v[j].y) + (v[j].z * v[j].z + v[j].w * v[j].w); }
            const float rstd = 1.f / sqrtf(wave_sum(s2) * (1.f / DM) + LN_EPS);
#pragma unroll
            for (int j = 0; j < 4; ++j) {
                const f32x4 gg = *((const f32x4*)lg + lane + 64 * j), bb = *((const f32x4*)lb + lane + 64 * j);
                xr[64 * j] = v[j] * rstd * gg + bb;
            }
        }
    }
}

extern "C" void kernel_launch(void* const* d_in, const int* in_sizes, int n_in, void* d_out, int out_size, void* d_ws, size_t ws_size, hipStream_t stream) {
    static int grid_blocks = 0;
    if (grid_blocks == 0) {
        int dev = 0, cus = 0, per_cu = 0;
        (void)hipGetDevice(&dev);
        (void)hipDeviceGetAttribute(&cus, hipDeviceAttributeMultiprocessorCount, dev);
        (void)hipFuncSetAttribute((const void*)fwd_kernel, hipFuncAttributeMaxDynamicSharedMemorySize, LDS_BYTES);
        (void)hipOccupancyMaxActiveBlocksPerMultiprocessor(&per_cu, (const void*)fwd_kernel, 512, LDS_BYTES);
        if (per_cu < 1) { fprintf(stderr, "kernel_launch: occupancy query returned %d\n", per_cu); per_cu = 1; }
        grid_blocks = cus * per_cu;
    }
    (void)hipMemsetAsync((unsigned char*)d_ws + WS_SMALL + SM_BAR, 0, 16384, stream);
    Params p{};
    for (int i = 0; i < 28; ++i) p.in[i] = (const float*)d_in[i];
    p.out = (float*)d_out; p.ws = (unsigned char*)d_ws;
    void* args[] = {&p};
    hipError_t e = hipLaunchCooperativeKernel((const void*)fwd_kernel, dim3(grid_blocks), dim3(512), args, LDS_BYTES, stream);
    if (e != hipSuccess) fprintf(stderr, "cooperative launch failed: %s (grid %d)\n", hipGetErrorString(e), grid_blocks);
}
```

```cpp
#include <hip/hip_runtime.h>
#include <hip/hip_cooperative_groups.h>
#include <cstdio>
#include <cstdint>
namespace cg = cooperative_groups;

#define LAS __attribute__((address_space(3)))
typedef unsigned short bf16_t;
typedef short bf16x8 __attribute__((ext_vector_type(8)));
typedef short s16x4 __attribute__((ext_vector_type(4)));
typedef float f32x4 __attribute__((ext_vector_type(4)));
typedef unsigned u32x4 __attribute__((ext_vector_type(4)));
typedef unsigned u32x2 __attribute__((ext_vector_type(2)));

constexpr int DM = 1024, NB = 8, SEQ = 2048, NMETA = 16, TP = SEQ + NMETA, DB = 128, DS = 8;
constexpr int RP = NB * TP;
constexpr int RS = DB * DS;
constexpr int MR = RP + RS;
constexpr int MP = 17664;
constexpr int DFF = 2816, DIN = 4104;
constexpr int NCH = 33;
constexpr int NSLOT = NB * 4 * NCH;
constexpr float ALPHA = 1.189207115002721f;
constexpr float LN_EPS = 1e-5f, RMS_EPS = 1e-6f;
constexpr float KSCALE = 0.08838834764831845f;

constexpr size_t MiB = 1u << 20;
constexpr size_t WS_WIN = 0, WS_WOUT = 8 * MiB, WS_WUP = 10 * MiB, WS_WDN = 21 * MiB;
constexpr size_t WS_SMALL = 27 * MiB;
constexpr size_t SM_STATS = 0;
constexpr size_t SM_IG = 160 * 1024;
constexpr size_t SM_LFA = SM_IG + 288 * 1024;
constexpr size_t SM_CHKL = SM_LFA + 288 * 1024;
constexpr size_t SM_CHKB = SM_CHKL + 8192;
constexpr size_t SM_MIN = SM_CHKB + 8192;
constexpr size_t SM_CHKN = SM_MIN + 8192;
constexpr size_t SM_NIN = SM_CHKN + 544 * 1024;
constexpr size_t SM_CHKA = SM_NIN + 544 * 1024;
constexpr size_t SM_BAR = SM_CHKA + 544 * 1024;
static_assert(SM_BAR + 16384 <= 4 * MiB, "small region");
constexpr size_t WS_BIG = 31 * MiB;
constexpr size_t SZ_R1024 = (size_t)MP * 1024 * 2;
constexpr size_t SZ_R512 = (size_t)MP * 512 * 2;
constexpr size_t SZ_CST = (size_t)NSLOT * 16384 * 2;
constexpr size_t WS_XN = WS_BIG, WS_CSTM = WS_BIG;
constexpr size_t WS_QAB = WS_BIG + SZ_R1024;
constexpr size_t WS_KA = WS_QAB + SZ_R1024, WS_VA = WS_KA + SZ_R512, WS_OA = WS_VA + SZ_R512, WS_IB = WS_OA + SZ_R512, WS_GB = WS_IB + SZ_R512;
constexpr size_t WS_FB = WS_GB + SZ_R512;
constexpr size_t WS_CSTH = WS_FB + SZ_R1024;
static_assert(WS_CSTH + SZ_CST <= 256 * MiB, "ws map (mixer)");
constexpr size_t WS_X1B = WS_BIG;
constexpr size_t WS_Z1 = WS_BIG + 2 * SZ_R1024;
constexpr size_t SZ_U = (size_t)MP * DFF * 2;
constexpr size_t WS_U = WS_BIG + SZ_R1024;
constexpr size_t WS_ACT = WS_U + SZ_U;
static_assert(WS_ACT + SZ_U <= 256 * MiB, "ws map (ffn)");

constexpr size_t O_YP = 0, O_CP = 17825792, O_NP = 18350080, O_MPR = 18354176, O_SP = 18354208, O_CVP = 18878496,
                 O_CS = 18923552, O_NS = 27312160, O_MS = 27377696, O_SS = 27378208, O_CVS = 35766816;

constexpr int LDS_BYTES = 155648;

struct Params { const float* in[28]; float* out; unsigned char* ws; };

typedef float f32x2_t __attribute__((ext_vector_type(2)));
typedef __bf16 bf16x2_t __attribute__((ext_vector_type(2)));
__device__ __forceinline__ unsigned pk2(float lo, float hi) { const f32x2_t v = {lo, hi}; const bf16x2_t b = __builtin_convertvector(v, bf16x2_t); return __builtin_bit_cast(unsigned, b); }
__device__ __forceinline__ unsigned f2bf(float f) { return pk2(f, 0.f) & 0xffffu; }
__device__ __forceinline__ float bflo(unsigned u) { return __uint_as_float(u << 16); }
__device__ __forceinline__ float bfhi(unsigned u) { return __uint_as_float(u & 0xffff0000u); }
__device__ __forceinline__ float bf2f(bf16_t h) { return __uint_as_float(((unsigned)h) << 16); }
__device__ __forceinline__ float wave_sum(float v) {
#pragma unroll
    for (int o = 1; o < 64; o <<= 1) v += __shfl_xor(v, o);
    return v;
}
__device__ __forceinline__ float frcp(float x) { return __builtin_amdgcn_rcpf(x); }
__device__ __forceinline__ float sigmoidf_(float x) { return frcp(1.0f + __expf(-x)); }
__device__ __forceinline__ float siluf_(float x) { return x * frcp(1.0f + __expf(-x)); }
__device__ __forceinline__ f32x4 exp4(const f32x4 x) {
    const f32x4 t = x * 1.4426950408889634f;
    f32x4 e; e[0] = __builtin_amdgcn_exp2f(t[0]); e[1] = __builtin_amdgcn_exp2f(t[1]); e[2] = __builtin_amdgcn_exp2f(t[2]); e[3] = __builtin_amdgcn_exp2f(t[3]);
    return e;
}
__device__ __forceinline__ f32x4 sigmoid4(const f32x4 x) {
    const f32x4 t = x * (-1.4426950408889634f);
    f32x4 e; e[0] = __builtin_amdgcn_exp2f(t[0]); e[1] = __builtin_amdgcn_exp2f(t[1]); e[2] = __builtin_amdgcn_exp2f(t[2]); e[3] = __builtin_amdgcn_exp2f(t[3]);
    const f32x4 d = e + 1.0f;
    f32x4 r; r[0] = __builtin_amdgcn_rcpf(d[0]); r[1] = __builtin_amdgcn_rcpf(d[1]); r[2] = __builtin_amdgcn_rcpf(d[2]); r[3] = __builtin_amdgcn_rcpf(d[3]);
    return r;
}
__device__ __forceinline__ const float* xrow_ptr(const float* xp, const float* xs, const float* meta, int r) {
    if (r < RP) { const int b = r / TP, q = r - b * TP; return q < NMETA ? meta + (size_t)q * DM : xp + ((size_t)b * SEQ + (q - NMETA)) * DM; }
    return xs + (size_t)(r - RP) * DM;
}
typedef __attribute__((address_space(4))) const Params* KP;
__device__ __forceinline__ KP kparams() { KP k = (KP)__builtin_amdgcn_kernarg_segment_ptr(); asm volatile("" : "+s"(k)); return k; }
#define KIN(i) (kparams()->in[i])
#define KOUT() (kparams()->out)
#define KWS() (kparams()->ws)

namespace pg8 {
constexpr int BM = 256, BK = 64, HALF = 128, HTB = HALF * BK * 2, STAGE_BYTES = 8 * HTB, NXCD = 8, WGM = 8;
__host__ __device__ __forceinline__ int lds_byte(int r, int c) { const int st = (r >> 4) * 2 + (c >> 5), rr = r & 15, cc = c & 31, ob = rr * 64 + cc * 2; return st * 1024 + (ob ^ (((ob >> 9) & 1) << 5)); }
__host__ __device__ __forceinline__ void stage_rc(int b, int& R, int& C) { const int st = b / 1024, sb = b % 1024, swz = sb ^ (((sb >> 9) & 1) << 5); R = (st >> 1) * 16 + swz / 64; C = (st & 1) * 32 + (swz % 64) / 2; }
__host__ __device__ __forceinline__ int perm32(int rho) { const int n = rho >> 4, i = rho & 15; return 8 * (i >> 2) + 4 * n + (i & 3); }
struct Unit { int pm, pn, k0, nk, split; };
struct Gemm { const bf16_t* A; const bf16_t* Bt; int M, N, K; };
struct StaticOrder {
    int nM, nN, nwg, G, c, ntk;
    __host__ __device__ void init(int M, int N, int G_, int c_, int K_ = 1024) { nM = M / BM; nN = N / BM; nwg = nM * nN; G = G_; c = c_; ntk = K_ / BK; }
    __host__ __device__ bool next(int i, Unit& u) const {
        u.k0 = 0; u.nk = ntk; u.split = 0;
        const long L = (long)i * G + c; if (L >= nwg) return false;
        int wgid = (int)L; { const int q = nwg / NXCD, r = nwg % NXCD, xcd = wgid % NXCD, off = wgid / NXCD; wgid = (xcd < r ? xcd * (q + 1) : r * (q + 1) + (xcd - r) * q) + off; }
        const int nig = WGM * nN, gid = wgid / nig, fm = gid * WGM, gsz = (nM - fm) < WGM ? (nM - fm) : WGM;
        u.pm = fm + ((wgid % nig) % gsz); u.pn = (wgid % nig) / gsz; return true;
    }
    __device__ __forceinline__ void a_ready(const Unit&) const {}
    __device__ __forceinline__ void done(const Unit&) const {}
};
__host__ __device__ __forceinline__ void map_unit(int wgid, int nM, int nN, int nwg, Unit& u) {
    { const int q = nwg / NXCD, r = nwg % NXCD, xcd = wgid % NXCD, off = wgid / NXCD; wgid = (xcd < r ? xcd * (q + 1) : r * (q + 1) + (xcd - r) * q) + off; }
    const int nig = WGM * nN, gid = wgid / nig, fm = gid * WGM, gsz = (nM - fm) < WGM ? (nM - fm) : WGM;
    u.pm = fm + ((wgid % nig) % gsz); u.pn = (wgid % nig) / gsz;
}
struct TailSplitOrder {
    int nM, nN, nwg, G, c, ntk, S, split_mode, nMf;
    __host__ __device__ __forceinline__ void init(int M, int N, int G_, int c_, int K_, int S_) {
        nM = M / BM; nN = N / BM; nwg = nM * nN; G = G_; c = c_; ntk = K_ / BK; S = S_; nMf = G_ / nN;
        const int R = nwg - G_;
        split_mode = (G_ % nN == 0) && R > 0 && R * S_ <= G_ && (ntk % (2 * S_) == 0);
    }
    __host__ __device__ __forceinline__ int tail_row0() const { return split_mode ? nMf * BM : (1 << 30); }
    __host__ __device__ __forceinline__ bool next(int i, Unit& u) const {
        u.k0 = 0; u.nk = ntk; u.split = 0;
        if (!split_mode) { const long L = (long)i * G + c; if (L >= nwg) return false; map_unit((int)L, nM, nN, nwg, u); return true; }
        if (i == 0) { map_unit(c, nMf, nN, G, u); return true; }
        if (i > 1) return false;
        const int R = nwg - G; if (c >= R * S) return false;
        const int t = c / S, piece = c - t * S;
        u.pm = nMf + t / nN; u.pn = t % nN; u.nk = ntk / S; u.k0 = piece * u.nk; u.split = piece + 1; return true;
    }
    __device__ __forceinline__ void a_ready(const Unit&) const {}
    __device__ __forceinline__ void done(const Unit&) const {}
};
__device__ __forceinline__ void atomic_add4(float* o, const f32x4 v) {
#pragma unroll
    for (int j = 0; j < 4; ++j) __hip_atomic_fetch_add(o + j, v[j], __ATOMIC_RELAXED, __HIP_MEMORY_SCOPE_AGENT);
}
__device__ __forceinline__ unsigned cvt_pk_bf16(float lo, float hi) { unsigned r; asm volatile("v_cvt_pk_bf16_f32 %0, %1, %2" : "=v"(r) : "v"(lo), "v"(hi)); return r; }

template <class Epi, class Sched, bool ALIGN_EPI = false, bool SP2 = false>
__device__ __forceinline__ void gemm_phase(LAS unsigned char* lds, const Gemm g, const Sched& S, const Epi& E) {
    int tid_l = threadIdx.x; asm volatile("" : "+v"(tid_l));
    const int tid = tid_l, wid = __builtin_amdgcn_readfirstlane(tid >> 6), lane = tid & 63, wr = wid >> 2, wc = wid & 3, fr = lane & 15, fq = lane >> 4;
    const int K = g.K;
    unsigned voffA[2], voffB[2];
#pragma unroll
    for (int i = 0; i < 2; ++i) { int R, C; stage_rc(tid * 16 + i * 8192, R, C); const int Rb = Epi::PERM ? ((R & ~31) + perm32(R & 31)) : R;
        voffA[i] = (unsigned)(R * K + C) * 2u; voffB[i] = (unsigned)(Rb * K + C) * 2u; }
    const size_t kstep = (size_t)(BK * 2);
    const size_t hstep = (size_t)HALF * K * 2;
    const size_t tstep = 2 * hstep;
    const unsigned ldsw = (unsigned)wid * 1024u;
    const int aoff = lds_byte(wr * 64 + fr, fq * 8), boff = lds_byte(wc * 32 + fr, fq * 8);
#define PG8_SA(b, h) (((b) * 2 + (h)) * HTB)
#define PG8_SB(b, h) ((4 + (b) * 2 + (h)) * HTB)
#define PG8_STAGE(bufoff, gbase, voff) do { _Pragma("unroll") for (int _i = 0; _i < 2; ++_i) \
        __builtin_amdgcn_global_load_lds((const unsigned*)((const char*)(gbase) + (voff)[_i]), (LAS unsigned*)(lds + (bufoff) + ldsw + _i * 8192), 16, 0, 0); } while (0)
#define PG8_LDA(dst, b, h) do { _Pragma("unroll") for (int m = 0; m < 4; ++m) _Pragma("unroll") for (int k = 0; k < 2; ++k) dst[m][k] = *(const LAS bf16x8*)(lds + PG8_SA(b, h) + aoff + m * 2048 + k * 1024); } while (0)
#define PG8_LDB(dst, b, h) do { _Pragma("unroll") for (int n = 0; n < 2; ++n) _Pragma("unroll") for (int k = 0; k < 2; ++k) dst[n][k] = *(const LAS bf16x8*)(lds + PG8_SB(b, h) + boff + n * 2048 + k * 1024); } while (0)
#define PG8_MMA(ai, bj, At, Bt) do { __builtin_amdgcn_s_setprio(1); _Pragma("unroll") for (int m = 0; m < 4; ++m) _Pragma("unroll") for (int n = 0; n < 2; ++n) _Pragma("unroll") for (int k = 0; k < 2; ++k) \
        acc[ai][bj][m][n] = __builtin_amdgcn_mfma_f32_16x16x32_bf16(Bt[n][k], At[m][k], acc[ai][bj][m][n], 0, 0, 0); __builtin_amdgcn_s_setprio(0); } while (0)
#define PG8_WAIT_V(n) asm volatile("s_waitcnt vmcnt(" #n ")" ::: "memory")
#define PG8_WAIT_L(n) asm volatile("s_waitcnt lgkmcnt(" #n ")" ::: "memory")
#define PG8_BAR __builtin_amdgcn_s_barrier()
#define PG8_SCHED __builtin_amdgcn_sched_barrier(0)
    Unit cur, nxt; int ui = 0;
    if (!S.next(0, cur)) return;
    f32x4 acc[2][2][4][2];
#pragma unroll
    for (int a = 0; a < 2; ++a)
#pragma unroll
        for (int b = 0; b < 2; ++b)
#pragma unroll
            for (int m = 0; m < 4; ++m)
#pragma unroll
                for (int n = 0; n < 2; ++n) acc[a][b][m][n] = (f32x4){0.f, 0.f, 0.f, 0.f};
    bf16x8 At[4][2], B0[2][2], B1[2][2];
    const char* cA = (const char*)g.A + (size_t)cur.pm * tstep + (size_t)cur.k0 * kstep; const char* cB = (const char*)g.Bt + (size_t)cur.pn * tstep + (size_t)cur.k0 * kstep;
    S.a_ready(cur);
    if constexpr (SP2) {
        PG8_STAGE(PG8_SB(0, 0), cB, voffB); PG8_STAGE(PG8_SB(0, 1), cB + hstep, voffB); PG8_STAGE(PG8_SA(0, 0), cA, voffA); PG8_STAGE(PG8_SA(0, 1), cA + hstep, voffA);
        if (wr == 1) PG8_BAR;
        PG8_WAIT_V(2); PG8_BAR;
        PG8_STAGE(PG8_SB(1, 0), cB + kstep, voffB); PG8_STAGE(PG8_SA(1, 0), cA + kstep, voffA); PG8_STAGE(PG8_SB(1, 1), cB + hstep + kstep, voffB);
        PG8_WAIT_V(6); PG8_BAR;
    } else {
        PG8_STAGE(PG8_SB(0, 0), cB, voffB); PG8_STAGE(PG8_SA(0, 0), cA, voffA); PG8_STAGE(PG8_SB(0, 1), cB + hstep, voffB); PG8_STAGE(PG8_SA(0, 1), cA + hstep, voffA);
        if (wr == 1) PG8_BAR;
        PG8_WAIT_V(4); PG8_BAR;
        PG8_STAGE(PG8_SB(1, 0), cB + kstep, voffB); PG8_STAGE(PG8_SA(1, 0), cA + kstep, voffA); PG8_STAGE(PG8_SB(1, 1), cB + hstep + kstep, voffB);
        PG8_WAIT_V(6); PG8_BAR;
    }
    for (;;) {
        const bool has_next = S.next(ui + 1, nxt);
        const char* nA = has_next ? (const char*)g.A + (size_t)nxt.pm * tstep + (size_t)nxt.k0 * kstep : cA; const char* nB = has_next ? (const char*)g.Bt + (size_t)nxt.pn * tstep + (size_t)nxt.k0 * kstep : cB;
        const int nt = cur.nk;
        for (int t = 0; t < nt; t += 2) {
            const bool last = (t == nt - 2);
            const char* a1 = cA + (size_t)(t + 1) * kstep;
            const char* a2 = last ? nA : cA + (size_t)(t + 2) * kstep; const char* b2 = last ? nB : cB + (size_t)(t + 2) * kstep;
            const char* a3 = a2 + kstep; const char* b3 = b2 + kstep;
            if (last && has_next) S.a_ready(nxt);
            if constexpr (SP2) {
            PG8_LDB(B0, 0, 0); PG8_LDB(B1, 0, 1); PG8_SCHED; PG8_LDA(At, 0, 0); PG8_STAGE(PG8_SA(1, 1), a1 + hstep, voffA);
            PG8_WAIT_V(8); PG8_WAIT_L(0); PG8_BAR; PG8_MMA(0, 0, At, B0); PG8_MMA(0, 1, At, B1); PG8_BAR; PG8_SCHED;
            PG8_LDA(At, 0, 1); PG8_STAGE(PG8_SB(0, 0), b2, voffB); PG8_STAGE(PG8_SB(0, 1), b2 + hstep, voffB); PG8_STAGE(PG8_SA(0, 0), a2, voffA);
            PG8_WAIT_V(8); PG8_WAIT_L(0); PG8_BAR; PG8_MMA(1, 0, At, B0); PG8_MMA(1, 1, At, B1); PG8_BAR; PG8_SCHED;
            PG8_LDB(B0, 1, 0); PG8_LDB(B1, 1, 1); PG8_SCHED; PG8_LDA(At, 1, 0); PG8_STAGE(PG8_SA(0, 1), a2 + hstep, voffA);
            PG8_WAIT_V(8); PG8_WAIT_L(0); PG8_BAR; PG8_MMA(0, 0, At, B0); PG8_MMA(0, 1, At, B1); PG8_BAR; PG8_SCHED;
            PG8_LDA(At, 1, 1); PG8_STAGE(PG8_SB(1, 0), b3, voffB); PG8_STAGE(PG8_SB(1, 1), b3 + hstep, voffB); PG8_STAGE(PG8_SA(1, 0), a3, voffA);
            PG8_WAIT_V(8); PG8_WAIT_L(0); PG8_BAR; PG8_MMA(1, 0, At, B0); PG8_MMA(1, 1, At, B1); PG8_BAR; PG8_SCHED;
            } else {
            PG8_LDB(B0, 0, 0); PG8_SCHED; PG8_LDA(At, 0, 0); PG8_STAGE(PG8_SA(1, 1), a1 + hstep, voffA);
            PG8_WAIT_L(8); PG8_BAR; PG8_WAIT_L(0); PG8_MMA(0, 0, At, B0); PG8_BAR; PG8_SCHED;
            PG8_LDB(B1, 0, 1); PG8_STAGE(PG8_SB(0, 0), b2, voffB);
            PG8_BAR; PG8_WAIT_L(0); PG8_MMA(0, 1, At, B1); PG8_BAR;
            PG8_LDA(At, 0, 1); PG8_STAGE(PG8_SA(0, 0), a2, voffA);
            PG8_BAR; PG8_WAIT_L(0); PG8_MMA(1, 0, At, B0); PG8_BAR; PG8_SCHED;
            PG8_STAGE(PG8_SB(0, 1), b2 + hstep, voffB);
            PG8_WAIT_V(6); PG8_BAR; PG8_MMA(1, 1, At, B1); PG8_BAR;
            PG8_LDB(B0, 1, 0); PG8_SCHED; PG8_LDA(At, 1, 0); PG8_STAGE(PG8_SA(0, 1), a2 + hstep, voffA);
            PG8_WAIT_L(8); PG8_BAR; PG8_WAIT_L(0); PG8_MMA(0, 0, At, B0); PG8_BAR; PG8_SCHED;
            PG8_LDB(B1, 1, 1); PG8_STAGE(PG8_SB(1, 0), b3, voffB);
            PG8_BAR; PG8_WAIT_L(0); PG8_MMA(0, 1, At, B1); PG8_BAR;
            PG8_LDA(At, 1, 1); PG8_STAGE(PG8_SA(1, 0), a3, voffA);
            PG8_BAR; PG8_WAIT_L(0); PG8_MMA(1, 0, At, B0); PG8_BAR; PG8_SCHED;
            PG8_STAGE(PG8_SB(1, 1), b3 + hstep, voffB);
            PG8_WAIT_V(6); PG8_BAR; PG8_MMA(1, 1, At, B1); PG8_BAR;
            }
        }
        if constexpr (ALIGN_EPI) { if (wr == 0) PG8_BAR; }
        E(acc, cur, wr, wc, fr, fq);
        if (!has_next) break;
#pragma unroll
        for (int a = 0; a < 2; ++a)
#pragma unroll
            for (int b = 0; b < 2; ++b)
#pragma unroll
                for (int m = 0; m < 4; ++m)
#pragma unroll
                    for (int n = 0; n < 2; ++n) acc[a][b][m][n] = (f32x4){0.f, 0.f, 0.f, 0.f};
        cur = nxt; cA = nA; cB = nB; ++ui;
        if constexpr (ALIGN_EPI) { if (wr == 1) PG8_BAR; }
    }
    PG8_WAIT_V(0);
    if constexpr (!ALIGN_EPI) { if (wr == 0) PG8_BAR; }
    PG8_BAR;
#undef PG8_SA
#undef PG8_SB
#undef PG8_STAGE
#undef PG8_LDA
#undef PG8_LDB
#undef PG8_MMA
#undef PG8_WAIT_V
#undef PG8_WAIT_L
#undef PG8_BAR
#undef PG8_SCHED
}

typedef f32x4 Acc[2][2][4][2];
constexpr size_t PART_STRIDE = (size_t)1280 * 1024;

struct EpiIn {
    static constexpr bool PERM = true;
    unsigned char* ws; const float* b_in;
    __device__ __forceinline__ void operator()(const Acc& acc, const Unit& u, int wr, int wc, int fr, int fq) const {
        const int g = u.pn >> 1;
        const int cg0 = (u.pn & 1) * 256 + wc * 32 + 8 * fq;
        const int bsrc0 = u.pn * 256 + wc * 32 + 8 * fq + (u.pn >= 8 ? 8 : 0);
        const int row0 = u.pm * BM + wr * 64 + fr;
        int mode = 0; size_t ld = 512; unsigned char* base;
        switch (g) {
            case 0: base = ws + WS_QAB; ld = 1024; break;
            case 1: base = ws + WS_KA; mode = 1; break;
            case 2: base = ws + WS_VA; break;
            case 3: base = ws + WS_OA; mode = 3; break;
            case 4: base = ws + WS_QAB + 1024; ld = 1024; mode = 2; break;
            case 5: base = ws + WS_FB; mode = 4; break;
            case 6: base = ws + WS_IB; break;
            default: base = ws + WS_GB; mode = 3; break;
        }
#pragma unroll
        for (int bj = 0; bj < 2; ++bj) {
            const f32x4 b0 = *(const f32x4*)(b_in + bsrc0 + bj * HALF), b1 = *(const f32x4*)(b_in + bsrc0 + bj * HALF + 4);
#pragma unroll
            for (int ai = 0; ai < 2; ++ai)
#pragma unroll
                for (int m = 0; m < 4; ++m) {
                    const size_t row = (size_t)(row0 + ai * HALF + m * 16);
                    f32x4 v0 = acc[ai][bj][m][0] + b0, v1 = acc[ai][bj][m][1] + b1;
                    if (mode == 4) { float* o = (float*)base + row * 512 + cg0 + bj * HALF; *(f32x4*)o = v0; *(f32x4*)(o + 4) = v1; continue; }
                    if (mode == 1) { v0 = v0 * KSCALE; v1 = v1 * KSCALE; }
                    else if (mode == 2) { v0 = v0 * sigmoid4(v0); v1 = v1 * sigmoid4(v1); }
                    else if (mode == 3) { v0 = sigmoid4(v0); v1 = sigmoid4(v1); }
                    u32x4 w; w.x = cvt_pk_bf16(v0[0], v0[1]); w.y = cvt_pk_bf16(v0[2], v0[3]); w.z = cvt_pk_bf16(v1[0], v1[1]); w.w = cvt_pk_bf16(v1[2], v1[3]);
                    *(u32x4*)((bf16_t*)base + row * ld + cg0 + bj * HALF) = w;
                }
        }
    }
};

struct EpiZ1 {
    static constexpr bool PERM = true;
    const float* xp; const float* xs; const float* meta; const float* gg; const float* gb; const float* bo; const float* stats; float* z1; float* tail; int tailrow0;
    __device__ __forceinline__ void operator()(const Acc& acc, const Unit& u, int wr, int wc, int fr, int fq) const {
        const int col0 = u.pn * BM + wc * 32 + 8 * fq;
#pragma unroll
        for (int bj = 0; bj < 2; ++bj) {
            const int col = col0 + bj * HALF;
            const f32x4 g0 = *(const f32x4*)(gg + col), g1 = *(const f32x4*)(gg + col + 4);
            const f32x4 c0 = *(const f32x4*)(gb + col) * ALPHA + *(const f32x4*)(bo + col), c1 = *(const f32x4*)(gb + col + 4) * ALPHA + *(const f32x4*)(bo + col + 4);
#pragma unroll
            for (int am = 0; am < 2; ++am) { const int ai = am, mb = 0;
                f32x4 xa[4], xb[4]; float mus[4], rss[4];
#pragma unroll
                for (int mm = 0; mm < 4; ++mm) { const int row = u.pm * BM + ai * HALF + wr * 64 + (mb + mm) * 16 + fr;
                    xa[mm] = (f32x4){0.f, 0.f, 0.f, 0.f}; xb[mm] = xa[mm]; mus[mm] = 0.f; rss[mm] = 0.f;
                    if (row < MR && u.split <= 1) { const float* xr = xrow_ptr(xp, xs, meta, row) + col; xa[mm] = *(const f32x4*)xr; xb[mm] = *(const f32x4*)(xr + 4); mus[mm] = stats[2 * row]; rss[mm] = stats[2 * row + 1] * ALPHA; } }
#pragma unroll
                for (int mm = 0; mm < 4; ++mm) { const int m = mb + mm;
                    const int row = u.pm * BM + ai * HALF + wr * 64 + m * 16 + fr;
                    f32x4 v0 = (f32x4){0.f, 0.f, 0.f, 0.f}, v1 = v0;
                    if (row < MR) {
                        v0 = acc[ai][bj][m][0]; v1 = acc[ai][bj][m][1];
                        if (u.split <= 1) { v0 = v0 + c0 + (xa[mm] - mus[mm]) * rss[mm] * g0; v1 = v1 + c1 + (xb[mm] - mus[mm]) * rss[mm] * g1; }
                    }
                    float* o = (u.split ? tail + (size_t)(u.split - 1) * PART_STRIDE + (size_t)(row - tailrow0) * DM : z1 + (size_t)row * DM) + col;
                    *(f32x4*)o = v0; *(f32x4*)(o + 4) = v1;
                }
            }
        }
    }
};

struct EpiU {
    static constexpr bool PERM = true;
    bf16_t* U; const float* b_up; float* out;
    __device__ __forceinline__ void operator()(const Acc& acc, const Unit& u, int wr, int wc, int fr, int fq) const {
        const int col0 = u.pn * BM + wc * 32 + 8 * fq;
#pragma unroll
        for (int bj = 0; bj < 2; ++bj) {
            const int col = col0 + bj * HALF;
            const f32x4 b0 = *(const f32x4*)(b_up + col), b1 = *(const f32x4*)(b_up + col + 4);
#pragma unroll
            for (int ai = 0; ai < 2; ++ai)
#pragma unroll
                for (int m = 0; m < 4; ++m) {
                    const int row = u.pm * BM + ai * HALF + wr * 64 + m * 16 + fr;
                    const f32x4 v0 = acc[ai][bj][m][0] + b0, v1 = acc[ai][bj][m][1] + b1;
                    u32x4 w; w.x = cvt_pk_bf16(v0[0], v0[1]); w.y = cvt_pk_bf16(v0[2], v0[3]); w.z = cvt_pk_bf16(v1[0], v1[1]); w.w = cvt_pk_bf16(v1[2], v1[3]);
                    *(u32x4*)(U + (size_t)row * DFF + col) = w;
                    float* o = nullptr;
                    if (row < RP) { const int b = row / TP, q = row - b * TP; if (q >= TP - 2) o = out + O_CVP + ((size_t)(b * 2 + (q - (TP - 2)))) * DFF + col; }
                    else if (row < MR) { const int s = row - RP, t = s & 7; if (t >= 6) o = out + O_CVS + ((size_t)((s >> 3) * 2 + (t - 6))) * DFF + col; }
                    if (o) { *(f32x4*)o = v0; *(f32x4*)(o + 4) = v1; }
                }
        }
    }
};

__device__ __forceinline__ f32x4 silu_mul4(const f32x4 x, const f32x4 g) {
    const f32x4 t = x * (-1.4426950408889634f);
    f32x4 e; e[0] = __builtin_amdgcn_exp2f(t[0]); e[1] = __builtin_amdgcn_exp2f(t[1]); e[2] = __builtin_amdgcn_exp2f(t[2]); e[3] = __builtin_amdgcn_exp2f(t[3]);
    const f32x4 d = e + 1.0f;
    f32x4 r; r[0] = __builtin_amdgcn_rcpf(d[0]); r[1] = __builtin_amdgcn_rcpf(d[1]); r[2] = __builtin_amdgcn_rcpf(d[2]); r[3] = __builtin_amdgcn_rcpf(d[3]);
    return (x * r) * g;
}
__device__ __forceinline__ void unpack8(const u32x4 w, f32x4& a, f32x4& b) { a = (f32x4){bflo(w.x), bfhi(w.x), bflo(w.y), bfhi(w.y)}; b = (f32x4){bflo(w.z), bfhi(w.z), bflo(w.w), bfhi(w.w)}; }
struct EpiAct {
    static constexpr bool PERM = true;
    const bf16_t* U; bf16_t* ACT; const float* b_upg; const float* w_conv; const float* b_conv; const float* cstate;
    __device__ __forceinline__ void operator()(const Acc& acc, const Unit& u, int wr, int wc, int fr, int fq) const {
        const int col0 = u.pn * BM + wc * 32 + 8 * fq;
#pragma unroll
        for (int bj = 0; bj < 2; ++bj) {
            const int col = col0 + bj * HALF;
            const f32x4 bg0 = *(const f32x4*)(b_upg + col), bg1 = *(const f32x4*)(b_upg + col + 4);
            const f32x4 bc0 = *(const f32x4*)(b_conv + col), bc1 = *(const f32x4*)(b_conv + col + 4);
            const f32x4 wa0 = *(const f32x4*)(w_conv + col), wa1 = *(const f32x4*)(w_conv + col + 4);
            const f32x4 wb0 = *(const f32x4*)(w_conv + DFF + col), wb1 = *(const f32x4*)(w_conv + DFF + col + 4);
            const f32x4 wc0 = *(const f32x4*)(w_conv + 2 * DFF + col), wc1 = *(const f32x4*)(w_conv + 2 * DFF + col + 4);
#pragma unroll
            for (int ai = 0; ai < 2; ++ai) {
                u32x4 own[4], halo = (u32x4){0u, 0u, 0u, 0u};
                const int hb = u.pm * BM + ai * HALF + wr * 64;
                own[0] = *(const u32x4*)(U + (size_t)(hb + fr) * DFF + col); own[1] = *(const u32x4*)(U + (size_t)(hb + 16 + fr) * DFF + col);
                if (fr >= 14) halo = *(const u32x4*)(U + (long)(hb - (16 - fr)) * DFF + col);
#pragma unroll
                for (int m = 0; m < 4; ++m) {
                    if (m == 1) { own[2] = *(const u32x4*)(U + (size_t)(hb + 32 + fr) * DFF + col); own[3] = *(const u32x4*)(U + (size_t)(hb + 48 + fr) * DFF + col); }
                    const int row = hb + m * 16 + fr;
                    const u32x4 prev = m ? own[m - 1] : halo;
                    u32x4 w1, w2;
#pragma unroll
                    for (int k = 0; k < 4; ++k) {
                        const int pr1 = __builtin_amdgcn_update_dpp(0, (int)prev[k], 0x121, 0xF, 0xF, true);
                        const int pr2 = __builtin_amdgcn_update_dpp(0, (int)prev[k], 0x122, 0xF, 0xF, true);
                        w1[k] = (unsigned)__builtin_amdgcn_update_dpp(pr1, (int)own[m][k], 0x111, 0xF, 0xF, false);
                        w2[k] = (unsigned)__builtin_amdgcn_update_dpp(pr2, (int)own[m][k], 0x112, 0xF, 0xF, false);
                    }
                    int t = 2;
                    if (row < RP) { const int b = row / TP; t = row - b * TP; } else if (row < MR) t = (row - RP) & 7;
                    f32x4 u00, u01, u10, u11, u20, u21;
                    unpack8(own[m], u00, u01); unpack8(w1, u10, u11); unpack8(w2, u20, u21);
                    if (__builtin_amdgcn_ballot_w64(t < 2) != 0ull) {
                        if (t < 1) { u10 = (f32x4){0.f, 0.f, 0.f, 0.f}; u11 = u10; }
                        if (t < 2) { u20 = (f32x4){0.f, 0.f, 0.f, 0.f}; u21 = u20; }
                        if (row >= RP && row < MR && t < 2) { const int s = row - RP;
                            const float* cs = cstate + (size_t)(s >> 3) * 2 * DFF + col;
                            const float* c2 = cs + (t == 1 ? DFF : 0); u20 = *(const f32x4*)c2; u21 = *(const f32x4*)(c2 + 4);
                            if (t == 0) { u10 = *(const f32x4*)(cs + DFF); u11 = *(const f32x4*)(cs + DFF + 4); } }
                    }
                    f32x4 cv0 = bc0 + wa0 * u20 + wb0 * u10 + wc0 * u00, cv1 = bc1 + wa1 * u21 + wb1 * u11 + wc1 * u01;
                    const f32x4 g0 = acc[ai][bj][m][0] + bg0, g1 = acc[ai][bj][m][1] + bg1;
                    cv0 = silu_mul4(cv0, g0); cv1 = silu_mul4(cv1, g1);
                    u32x4 w; w.x = cvt_pk_bf16(cv0[0], cv0[1]); w.y = cvt_pk_bf16(cv0[2], cv0[3]); w.z = cvt_pk_bf16(cv1[0], cv1[1]); w.w = cvt_pk_bf16(cv1[2], cv1[3]);
                    *(u32x4*)(ACT + (size_t)row * DFF + col) = w;
                }
            }
        }
    }
};

struct EpiZ2 {
    static constexpr bool PERM = true;
    const bf16_t* X1B; const float* b_dn; float* out; float* part; int tailrow0;
    __device__ __forceinline__ void operator()(const Acc& acc, const Unit& u, int wr, int wc, int fr, int fq) const {
        const int col0 = u.pn * BM + wc * 32 + 8 * fq;
#pragma unroll
        for (int bj = 0; bj < 2; ++bj) {
            const int col = col0 + bj * HALF;
            const f32x4 b0 = *(const f32x4*)(b_dn + col), b1 = *(const f32x4*)(b_dn + col + 4);
#pragma unroll
            for (int ai = 0; ai < 2; ++ai) {
                u32x4 xr[4];
#pragma unroll
                for (int m = 0; m < 4; ++m) xr[m] = *(const u32x4*)(X1B + (size_t)(u.pm * BM + ai * HALF + wr * 64 + m * 16 + fr) * DM + col);
#pragma unroll
                for (int m = 0; m < 4; ++m) {
                    const int row = u.pm * BM + ai * HALF + wr * 64 + m * 16 + fr;
                    long yrow = -1;
                    if (row < RP) { const int b = row / TP, q = row - b * TP; if (q >= NMETA) yrow = (long)b * SEQ + (q - NMETA); }
                    else if (row < MR) yrow = (long)NB * SEQ + (row - RP);
                    if (yrow >= 0 || u.split) {
                        f32x4 v0 = acc[ai][bj][m][0], v1 = acc[ai][bj][m][1];
                        if (u.split <= 1) { f32x4 x0, x1; unpack8(xr[m], x0, x1); v0 = v0 + b0 + x0 * ALPHA; v1 = v1 + b1 + x1 * ALPHA; }
                        float* o = (u.split ? part + (size_t)(u.split - 1) * PART_STRIDE + (size_t)(row - tailrow0) * DM : out + (size_t)yrow * DM) + col;
                        *(f32x4*)o = v0; *(f32x4*)(o + 4) = v1;
                    }
                }
            }
        }
    }
};
}

constexpr int LQ = 0, LK = 17408, LV = 34816, LC = 52224, LSW = 87040, LA = 96256, LVEC = 129024;
constexpr int RSTR = 272, SWSTR = 144;
constexpr int V_BM = 0, V_AV = 64, V_DEC = 128, V_EM = 192, V_DENQ = 256, V_DENI = 320, V_SSQ = 384, V_WT = 448, V_NIN = 512, V_PSUM = 640, V_MISC = 1152;
constexpr int LG = LVEC + (V_MISC + 16) * 4;
constexpr int LGN = LG + 64 * RSTR;
static_assert(LG % 16 == 0 && LGN % 16 == 0 && LGN + 4096 <= LDS_BYTES - 16, "mixer LDS map");

__device__ __forceinline__ bf16x8 rowfrag(LAS unsigned char* base, int stride, int row0, int k0, int lane) {
    return *(const LAS bf16x8*)(base + (row0 + (lane & 15)) * stride + (k0 + 8 * (lane >> 4)) * 2);
}
__device__ __forceinline__ bf16x8 trfrag(LAS unsigned char* base, int stride, int k0, int c0, int lane) {
    const int g = lane >> 4, q = (lane & 15) >> 2, pp = lane & 3;
    LAS unsigned char* a = base + (k0 + 8 * g + q) * stride + (c0 + 4 * pp) * 2;
    const s16x4 lo = __builtin_amdgcn_ds_read_tr16_b64_v4i16((LAS s16x4*)a);
    const s16x4 hi = __builtin_amdgcn_ds_read_tr16_b64_v4i16((LAS s16x4*)(a + 4 * stride));
    return (bf16x8){lo[0], lo[1], lo[2], lo[3], hi[0], hi[1], hi[2], hi[3]};
}
__device__ __forceinline__ void load_chunk(LAS unsigned char* dst, const bf16_t* src, size_t ldg, int len, int tid) {
#pragma unroll
    for (int i = 0; i < 2; ++i) { const int q = tid + i * 512, s = q >> 4, cc = q & 15;
        u32x4 v = (u32x4){0u, 0u, 0u, 0u}; if (s < len) v = *(const u32x4*)(src + (size_t)s * ldg + cc * 8);
        *(LAS u32x4*)(dst + s * RSTR + cc * 16) = v; }
}
__device__ __forceinline__ void chunk_ld(u32x4 (&r)[2], const bf16_t* src, size_t ldg, int len, int tid) {
#pragma unroll
    for (int i = 0; i < 2; ++i) { const int q = tid + i * 512, s = q >> 4, cc = q & 15; r[i] = (u32x4){0u, 0u, 0u, 0u}; if (s < len) r[i] = *(const u32x4*)(src + (size_t)s * ldg + cc * 8); }
}
__device__ __forceinline__ void chunk_st(LAS unsigned char* dst, const u32x4 (&r)[2], int tid) {
#pragma unroll
    for (int i = 0; i < 2; ++i) { const int q = tid + i * 512, s = q >> 4, cc = q & 15; *(LAS u32x4*)(dst + s * RSTR + cc * 16) = r[i]; }
}
__device__ __forceinline__ void fb_ld(f32x4 (&fbv)[4], const float* FBsrc, int len, int tid) {
    const int c4 = tid & 31, sr = tid >> 5;
#pragma unroll
    for (int j = 0; j < 4; ++j) { const int s = sr + 16 * j; fbv[j] = (f32x4){0.f, 0.f, 0.f, 0.f}; if (s < len) fbv[j] = *(const f32x4*)(FBsrc + (size_t)s * 512 + c4 * 4); }
}
__device__ __forceinline__ void hgrn_prep(LAS unsigned char* lds, const f32x4 (&fbv)[4], const float* lbl, int h, int len, int tid) {
    LAS float* A = (LAS float*)(lds + LA); LAS float* vec = (LAS float*)(lds + LVEC);
    const int cch = tid & 127, part = tid >> 7;
    { const int c4 = tid & 31, sr = tid >> 5;
      const f32x4 l0 = *(const f32x4*)(lbl + h * 128 + c4 * 4), l1 = *(const f32x4*)(lbl + 512 + h * 128 + c4 * 4);
      const f32x4 lb4 = sigmoid4(l0 - l1), oml = 1.0f - lb4;
#pragma unroll
      for (int j = 0; j < 4; ++j) { const int s = sr + 16 * j;
        f32x4 lf = (f32x4){0.f, 0.f, 0.f, 0.f}, kb = lf;
        if (s < len) {
            const f32x4 sg = sigmoid4(fbv[j]), f = lb4 + oml * sg;
            lf[0] = __builtin_amdgcn_logf(f[0]); lf[1] = __builtin_amdgcn_logf(f[1]); lf[2] = __builtin_amdgcn_logf(f[2]); lf[3] = __builtin_amdgcn_logf(f[3]);
            lf = lf * 0.6931471805599453f; kb = oml * (1.0f - sg); }
        *(LAS f32x4*)(A + s * 128 + c4 * 4) = lf;
        u32x2 w; w.x = pk2(kb[0], kb[1]); w.y = pk2(kb[2], kb[3]); *(LAS u32x2*)(lds + LK + s * RSTR + c4 * 8) = w; } }
    __syncthreads();
    float v[16]; float run = 0.f;
#pragma unroll
    for (int i = 0; i < 16; ++i) { run += A[(part * 16 + i) * 128 + cch]; v[i] = run; }
    vec[V_PSUM + part * 128 + cch] = run;
    __syncthreads();
    float off = 0.f;
#pragma unroll
    for (int pp = 0; pp < 3; ++pp) if (pp < part) off += vec[V_PSUM + pp * 128 + cch];
#pragma unroll
    for (int i = 0; i < 16; ++i) A[(part * 16 + i) * 128 + cch] = v[i] + off;
    __syncthreads();
}

__device__ __forceinline__ void transpose_item(const float* W, int ldw, int K, bf16_t* WT, int k0, int n0, int sn0, LAS float* scr, int lane) {
    float tv[32];
#pragma unroll
    for (int i = 0; i < 32; ++i) { const int kk = 2 * i + (lane >> 5); tv[i] = W[(size_t)(k0 + kk) * ldw + sn0 + (lane & 31)]; }
#pragma unroll
    for (int i = 0; i < 32; ++i) { const int kk = 2 * i + (lane >> 5); scr[kk * 33 + (lane & 31)] = tv[i]; }
    asm volatile("s_waitcnt lgkmcnt(0)" ::: "memory");
    const int c = lane & 7;
#pragma unroll
    for (int j = 0; j < 4; ++j) { const int n = (lane >> 3) + 8 * j; const LAS float* s = scr + (8 * c) * 33 + n;
        u32x4 o; o.x = pk2(s[0 * 33], s[1 * 33]); o.y = pk2(s[2 * 33], s[3 * 33]); o.z = pk2(s[4 * 33], s[5 * 33]); o.w = pk2(s[6 * 33], s[7 * 33]);
        *(u32x4*)(WT + (size_t)(n0 + n) * K + k0 + 8 * c) = o; }
    asm volatile("s_waitcnt lgkmcnt(0)" ::: "memory");
}
#define XB_TMO      128
#define XB_XCNT(j)  (256  + 64 * (j))
#define XB_XSUB(j)  (1280 + 64 * (j))
#define XB_XGEN(j)  (2304 + 64 * (j))
#define XB_TOP      3328
#define XB_TOPGEN   3392
#define XCD_BAR_WORDS 3456
#define XB_SPIN_CAP (1u << 18)
__device__ __forceinline__ unsigned xb_ld(unsigned* p)              { return __hip_atomic_load(p, __ATOMIC_RELAXED, __HIP_MEMORY_SCOPE_AGENT); }
__device__ __forceinline__ unsigned xb_add(unsigned* p, unsigned v) { return __hip_atomic_fetch_add(p, v, __ATOMIC_RELAXED, __HIP_MEMORY_SCOPE_AGENT); }
__device__ __forceinline__ unsigned xb_xcc_id() { return (unsigned)__builtin_amdgcn_s_getreg((3 << 11) | 20) & 0xFu; }
#define XB_SPIN(cond, bar) do { unsigned _sp = 0; while (cond) { __builtin_amdgcn_s_sleep(1); \
    if ((++_sp & 255u) == 0u) { if (xb_ld(&(bar)[XB_TMO])) break; if (_sp > XB_SPIN_CAP) { atomicAdd(&(bar)[XB_TMO], 1u); break; } } } } while (0)
struct XcdBarrier { unsigned* bar; unsigned x; volatile LAS unsigned* st; };
__device__ __forceinline__ XcdBarrier xcd_barrier_post(unsigned* bar, volatile LAS unsigned* st) {
    XcdBarrier b; b.bar = bar; b.x = xb_xcc_id(); b.st = st;
    if (threadIdx.x == 0) (void)xb_add(&bar[XB_XCNT(b.x)], 1u);
    return b;
}
__device__ __forceinline__ void xcd_barrier_complete(unsigned* bar, unsigned x, unsigned& nloc, unsigned& nx) {
    const unsigned G = gridDim.x * gridDim.y * gridDim.z;
    unsigned sum, cnt, mine, sp = 0u;
    for (;;) {
        sum = 0u; cnt = 0u; mine = 0u;
#pragma unroll
        for (unsigned j = 0; j < 16; ++j) { const unsigned c = xb_ld(&bar[XB_XCNT(j)]); sum += c; cnt += (c > 0u) ? 1u : 0u; mine = (j == x) ? c : mine; }
        if (sum == G) break;
        __builtin_amdgcn_s_sleep(1);
        if ((++sp & 255u) == 0u) { if (xb_ld(&bar[XB_TMO])) break; if (sp > XB_SPIN_CAP) { atomicAdd(&bar[XB_TMO], 1u); break; } }
    }
    nloc = mine > 0u ? mine : 1u; nx = cnt > 0u ? cnt : 1u;
}
__device__ __forceinline__ void xcd_barrier(const XcdBarrier& b) {
    asm volatile("s_waitcnt vmcnt(0)" ::: "memory");
    __syncthreads();
    if (threadIdx.x == 0) {
        unsigned* bar = b.bar;
        __builtin_amdgcn_s_waitcnt(0);
        unsigned nloc = b.st[0], nx = b.st[1];
        if (nloc == 0u) { xcd_barrier_complete(bar, b.x, nloc, nx); b.st[0] = nloc; b.st[1] = nx; }
        const unsigned old = xb_add(&bar[XB_XSUB(b.x)], 1u);
        const unsigned gen = old / nloc;
        if (old + 1u == (gen + 1u) * nloc) {
            __builtin_amdgcn_fence(__ATOMIC_RELEASE, "agent");
            asm volatile("s_waitcnt vmcnt(0)" ::: "memory");
            const unsigned og = xb_add(&bar[XB_TOP], 1u);
            const unsigned tg = og / nx;
            if (og + 1u == (tg + 1u) * nx) xb_add(&bar[XB_TOPGEN], 1u);
            else XB_SPIN(xb_ld(&bar[XB_TOPGEN]) == tg, bar);
            __builtin_amdgcn_fence(__ATOMIC_ACQUIRE, "agent");
            xb_add(&bar[XB_XGEN(b.x)], 1u);
            asm volatile("s_waitcnt vmcnt(0)" ::: "memory");
        } else {
            XB_SPIN(xb_ld(&bar[XB_XGEN(b.x)]) == gen, bar);
            __builtin_amdgcn_fence(__ATOMIC_ACQUIRE, "agent");
            asm volatile("s_waitcnt vmcnt(0)" ::: "memory");
        }
    }
    __syncthreads();
}
#ifndef REP_P4
#define REP_P4 1
#endif
#ifndef REP_BAR
#define REP_BAR 1
#endif
#ifndef DBG_STOP
#define DBG_STOP -1
#endif
__device__ __forceinline__ void digest(float* out, const unsigned* w, size_t nwords, bool first, size_t gtid, size_t gthreads) {
    const size_t OUTN = 16777216;
    for (size_t i = gtid; i < OUTN; i += gthreads) { float a = first ? 0.f : out[i];
        for (size_t j = i; j < nwords; j += OUTN) { const unsigned x = w[j]; a += (float)(x & 0xffffu) * (1.f / 65536.f) + (float)(x >> 16) * (1.f / 65536.f); }
        out[i] = a; }
}
#define DG(off, bytes, first) digest(KOUT(), (const unsigned*)(KWS() + (off)), (size_t)(bytes) / 4, first, (size_t)bx * 512 + tid, (size_t)G * 512)
__global__ void __launch_bounds__(512, 2) fwd_kernel(Params p) {
    extern __shared__ __attribute__((aligned(16))) unsigned char lds_raw[];
    LAS unsigned char* lds = (LAS unsigned char*)lds_raw;
    const int tid = threadIdx.x, lane = tid & 63, wave = __builtin_amdgcn_readfirstlane(tid >> 6);
    const int G = gridDim.x, bx = blockIdx.x;
#define stats ((float*)(ws + WS_SMALL + SM_STATS))
#define IG ((float*)(ws + WS_SMALL + SM_IG))
#define LFA ((float*)(ws + WS_SMALL + SM_LFA))
#define CHKL ((float*)(ws + WS_SMALL + SM_CHKL))
#define CHKB ((float*)(ws + WS_SMALL + SM_CHKB))
#define MIN_ ((float*)(ws + WS_SMALL + SM_MIN))
#define CHKN ((float*)(ws + WS_SMALL + SM_CHKN))
#define NIN ((float*)(ws + WS_SMALL + SM_NIN))
#define CHKA ((float*)(ws + WS_SMALL + SM_CHKA))
    LAS float* vec = (LAS float*)(lds + LVEC);
    { volatile LAS unsigned* st0 = (volatile LAS unsigned*)(lds + LDS_BYTES - 16); if (tid < 4) st0[tid] = 0u; }
    __syncthreads();
    const XcdBarrier xbar = xcd_barrier_post((unsigned*)(KWS() + WS_SMALL + SM_BAR), (volatile LAS unsigned*)(lds + LDS_BYTES - 16));
#define GSYNC() xcd_barrier(xbar)

    {
        unsigned char* const ws = KWS();
        const int gw = bx * 8 + wave, NGW = G * 8;
        LAS float* scr = (LAS float*)(lds + wave * 8448);
        { const float* W = KIN(10); bf16_t* WT = (bf16_t*)(ws + WS_WIN);
          for (int it = gw; it < 16 * 128; it += NGW) { const int kb = it >> 7, nb = it & 127, n0 = 32 * nb; transpose_item(W, DIN, 1024, WT, 64 * kb, n0, n0 >= 2048 ? n0 + 8 : n0, scr, lane); } }
        __syncthreads();
        LAS float* wg = (LAS float*)(lds + 69632);
        { const float* win = KIN(10); float wv[16];
#pragma unroll
          for (int i = 0; i < 16; ++i) { const int idx = tid + i * 512; wv[i] = win[(size_t)(idx >> 3) * DIN + 2048 + (idx & 7)]; }
#pragma unroll
          for (int i = 0; i < 16; ++i) { const int idx = tid + i * 512; wg[(idx & 7) * 1024 + (idx >> 3)] = wv[i]; } }
        __syncthreads();
        bf16_t* XN = (bf16_t*)(ws + WS_XN);
        const float* lg = KIN(8); const float* lb = KIN(9);
        const float* xpr = KIN(0); const float* xsm = KIN(1); const float* meta = KIN(7);
        float bi_i = 0.f, bi_f = 0.f;
        if (lane < 4) { bi_i = KIN(11)[2048 + lane]; bi_f = KIN(11)[2052 + lane] + KIN(12)[lane]; }
        f32x4 nv[4];
        if (gw < MR) { const f32x4* x0 = (const f32x4*)xrow_ptr(xpr, xsm, meta, gw) + lane;
#pragma unroll
            for (int j = 0; j < 4; ++j) nv[j] = x0[64 * j]; }
        for (int r = gw; r < MP; r += NGW) {
            unsigned long long* o8 = (unsigned long long*)(XN + (size_t)r * DM) + lane;
            f32x4 v[4]; float s = 0.f;
#pragma unroll
            for (int j = 0; j < 4; ++j) v[j] = nv[j];
            if (r + NGW < MR) { const f32x4* xn = (const f32x4*)xrow_ptr(xpr, xsm, meta, r + NGW) + lane;
#pragma unroll
                for (int j = 0; j < 4; ++j) nv[j] = xn[64 * j]; }
            if (r >= MR) {
#pragma unroll
                for (int j = 0; j < 4; ++j) o8[64 * j] = 0ull;
                continue; }
#pragma unroll
            for (int j = 0; j < 4; ++j) s += (v[j].x + v[j].y) + (v[j].z + v[j].w);
            const float mean = wave_sum(s) * (1.f / DM); float s2 = 0.f;
#pragma unroll
            for (int j = 0; j < 4; ++j) { v[j] = v[j] - mean; s2 += (v[j].x * v[j].x + v[j].y * v[j].y) + (v[j].z * v[j].z + v[j].w * v[j].w); }
            const float rstd = 1.f / sqrtf(wave_sum(s2) * (1.f / DM) + LN_EPS);
            float gd[8];
#pragma unroll
            for (int g = 0; g < 8; ++g) gd[g] = 0.f;
#pragma unroll
            for (int j = 0; j < 4; ++j) {
                const f32x4 gg = *((const f32x4*)lg + lane + 64 * j), bb = *((const f32x4*)lb + lane + 64 * j);
                v[j] = v[j] * rstd * gg + bb;
                o8[64 * j] = (unsigned long long)pk2(v[j].x, v[j].y) | ((unsigned long long)pk2(v[j].z, v[j].w) << 32);
#pragma unroll
                for (int g = 0; g < 8; ++g) { const f32x4 w = *((const LAS f32x4*)(wg + g * 1024) + lane + 64 * j); gd[g] += (v[j].x * w.x + v[j].y * w.y) + (v[j].z * w.z + v[j].w * w.w); }
            }
#pragma unroll
            for (int g = 0; g < 8; ++g) gd[g] = wave_sum(gd[g]);
            if (lane == 0) { stats[2 * r] = mean; stats[2 * r + 1] = rstd; }
            if (lane < 4) {
                float gi = gd[0], gf = gd[4];
                if (lane == 1) { gi = gd[1]; gf = gd[5]; } else if (lane == 2) { gi = gd[2]; gf = gd[6]; } else if (lane == 3) { gi = gd[3]; gf = gd[7]; }
                IG[r * 4 + lane] = gi + bi_i;
                const float x = gf + bi_f;
                LFA[r * 4 + lane] = (x < 0.f) ? x - log1pf(expf(x)) : -log1pf(expf(-x));
            }
        }
    }
    GSYNC();
    if (DBG_STOP == 0) { DG(0, 26 * MiB + 512 * 1024, true); DG(WS_XN, SZ_R1024, false); DG(WS_SMALL + SM_STATS, (size_t)MR * 8, false); DG(WS_SMALL + SM_IG, (size_t)MR * 16, false); DG(WS_SMALL + SM_LFA, (size_t)MR * 16, false); return; }

    {
        unsigned char* const ws = KWS();
        pg8::Gemm g{(const bf16_t*)(ws + WS_XN), (const bf16_t*)(ws + WS_WIN), MP, 4096, 1024}; pg8::StaticOrder S; S.init(MP, 4096, G, bx);
        pg8::EpiIn E{ws, KIN(11)};
        pg8::gemm_phase<pg8::EpiIn, pg8::StaticOrder, true, true>(lds, g, S, E);
        {
            const int nwg = (MP / 256) * 16, rem = nwg % G, nfree = rem ? G - rem : G, fb = rem ? bx - rem : bx;
            if (fb >= 0) {
                LAS float* scr = (LAS float*)(lds + wave * 8448);
                constexpr int I_OUT = 16 * 32, I_UP = 16 * 176, I_DN = 44 * 32;
                for (int it = fb * 8 + wave; it < I_OUT + I_UP + I_DN; it += nfree * 8) {
                    int r = it;
                    if (r < I_OUT) { transpose_item(KIN(16), 1024, 1024, (bf16_t*)(ws + WS_WOUT), 64 * (r / 32), 32 * (r % 32), 32 * (r % 32), scr, lane); continue; } r -= I_OUT;
                    if (r < I_UP) { transpose_item(KIN(20), 2 * DFF, 1024, (bf16_t*)(ws + WS_WUP), 64 * (r / 176), 32 * (r % 176), 32 * (r % 176), scr, lane); continue; } r -= I_UP;
                    transpose_item(KIN(24), 1024, DFF, (bf16_t*)(ws + WS_WDN), 64 * (r / 32), 32 * (r % 32), 32 * (r % 32), scr, lane);
                }
            }
        }
    }
    GSYNC();
    if (DBG_STOP == 1) { DG(WS_QAB, SZ_R1024 + 5 * SZ_R512 + SZ_R1024, true); return; }

    { unsigned char* const ws = KWS(); const float* lbl = KIN(15);
    for (int item = bx; item < 2 * NSLOT; item += G) {
        const int type = item / NSLOT, j = item - type * NSLOT, b = j / 132, rem = j - b * 132, h = rem / NCH, c = rem - h * NCH;
        const int p0 = c ? NMETA + (c - 1) * 64 : 0, len = c ? 64 : NMETA, r0 = b * TP + p0;
        u32x4 rk[2], rv[2]; f32x4 fbv[4];
        chunk_ld(rv, (const bf16_t*)(ws + (type ? WS_IB : WS_VA)) + (size_t)r0 * 512 + h * 128, 512, len, tid);
        if (type == 0) chunk_ld(rk, (const bf16_t*)(ws + WS_KA) + (size_t)r0 * 512 + h * 128, 512, len, tid);
        else fb_ld(fbv, (const float*)(ws + WS_FB) + (size_t)r0 * 512 + h * 128, len, tid);
        __syncthreads();
        chunk_st(lds + LV, rv, tid);
        if (type == 0) {
            if (wave == 0) {
                const bool valid = lane < len;
                const float ig = valid ? IG[(r0 + lane) * 4 + h] : 0.f; float bc = valid ? LFA[(r0 + lane) * 4 + h] : 0.f;
#pragma unroll
                for (int o = 1; o < 64; o <<= 1) { const float t = __shfl_up(bc, o); if (lane >= o) bc += t; }
                const float a = valid ? ig - bc : -INFINITY; float mx = a;
#pragma unroll
                for (int o = 1; o < 64; o <<= 1) mx = fmaxf(mx, __shfl_xor(mx, o));
                const float bT = __shfl(bc, len - 1);
                vec[V_WT + lane] = valid ? __expf(a - mx) : 0.f;
                if (lane == 0) { CHKL[j] = mx; CHKB[j] = bT; }
            }
            __syncthreads();
#pragma unroll
            for (int i = 0; i < 2; ++i) { const int q = tid + i * 512, s = q >> 4, cc = q & 15;
                u32x4 v = rk[i];
                if (s < len) { const float w = vec[V_WT + s];
                    v.x = pk2(bflo(v.x) * w, bfhi(v.x) * w); v.y = pk2(bflo(v.y) * w, bfhi(v.y) * w); v.z = pk2(bflo(v.z) * w, bfhi(v.z) * w); v.w = pk2(bflo(v.w) * w, bfhi(v.w) * w); }
                *(LAS u32x4*)(lds + LK + s * RSTR + cc * 16) = v; }
            __syncthreads();
            if (tid < 128) { float s = 0.f;
#pragma unroll 8
                for (int q = 0; q < 64; ++q) s += bf2f(*(const LAS bf16_t*)(lds + LK + q * RSTR + tid * 2));
                CHKN[j * 128 + tid] = s; }
        } else {
            hgrn_prep(lds, fbv, lbl, h, len, tid);
            LAS float* A = (LAS float*)(lds + LA);
            const int cch = tid & 127, part = tid >> 7;
            const float aT = A[(len - 1) * 128 + cch];
            if (tid < 128) CHKA[j * 128 + tid] = aT;
            { const int c4 = tid & 31, sr = tid >> 5;
              const f32x4 aT4 = *(const LAS f32x4*)(A + (len - 1) * 128 + c4 * 4);
#pragma unroll
              for (int jj = 0; jj < 4; ++jj) { const int s = sr + 16 * jj;
                const f32x4 a4 = *(const LAS f32x4*)(A + s * 128 + c4 * 4);
                LAS u32x2* kp = (LAS u32x2*)(lds + LK + s * RSTR + c4 * 8); const u32x2 kw = *kp;
                const f32x4 k4 = exp4(aT4 - a4) * (f32x4){bflo(kw.x), bfhi(kw.x), bflo(kw.y), bfhi(kw.y)};
                u32x2 o; o.x = pk2(k4[0], k4[1]); o.y = pk2(k4[2], k4[3]); *kp = o; } }
            __syncthreads();
        }
        {
            bf16_t* dst = (bf16_t*)(ws + (type ? WS_CSTH : WS_CSTM)) + (size_t)j * 16384;
            const int e0 = 16 * wave;
            const bf16x8 a0 = trfrag(lds + LV, RSTR, 0, e0, lane), a1 = trfrag(lds + LV, RSTR, 32, e0, lane);
#pragma unroll 2
            for (int dt = 0; dt < 8; ++dt) {
                f32x4 acc = (f32x4){0.f, 0.f, 0.f, 0.f};
                const bf16x8 b0 = trfrag(lds + LK, RSTR, 0, 16 * dt, lane), b1 = trfrag(lds + LK, RSTR, 32, 16 * dt, lane);
                acc = __builtin_amdgcn_mfma_f32_16x16x32_bf16(a0, b0, acc, 0, 0, 0);
                acc = __builtin_amdgcn_mfma_f32_16x16x32_bf16(a1, b1, acc, 0, 0, 0);
                u32x2 w; w.x = pk2(acc[0], acc[1]); w.y = pk2(acc[2], acc[3]);
                *(u32x2*)(dst + (16 * dt + (lane & 15)) * 128 + e0 + 4 * (lane >> 4)) = w;
            }
        }
    } }
    GSYNC();
    if (DBG_STOP == 2) { DG(WS_CSTM, SZ_CST, true); DG(WS_CSTH, SZ_CST, false); DG(WS_SMALL + SM_CHKL, NSLOT * 4, false); DG(WS_SMALL + SM_CHKB, NSLOT * 4, false); DG(WS_SMALL + SM_CHKN, NSLOT * 512, false); DG(WS_SMALL + SM_CHKA, NSLOT * 512, false); return; }

    { unsigned char* const ws = KWS(); float* const outp = KOUT();
    for (int unit = bx; unit < 2 * NB * 4 * 4; unit += G) {
        const int type = unit >> 7, sq = (unit >> 2) & 31, quarter = unit & 3;
        const int eo = quarter * 4096 + tid * 8, d = eo >> 7;
        bf16_t* base = (bf16_t*)(ws + (type ? WS_CSTH : WS_CSTM)) + (size_t)sq * NCH * 16384 + eo;
        const bool nthr = (type == 0 && quarter == 0 && tid < 128);
        __syncthreads();
        if (type == 0 && tid < NCH) { vec[tid] = CHKL[sq * NCH + tid]; vec[64 + tid] = CHKB[sq * NCH + tid]; }
        __syncthreads();
        float carry[8];
#pragma unroll
        for (int i = 0; i < 8; ++i) carry[i] = 0.f;
        float m_in = 0.f, ncar = 0.f;
#pragma unroll 1
        for (int cg = 0; cg < NCH; cg += 11) {
            u32x4 uu[11]; float aux[11];
#pragma unroll
            for (int k = 0; k < 11; ++k) uu[k] = *(const u32x4*)(base + (size_t)(cg + k) * 16384);
#pragma unroll
            for (int k = 0; k < 11; ++k) aux[k] = (type == 0) ? (nthr ? CHKN[(sq * NCH + cg + k) * 128 + tid] : 0.f) : CHKA[(sq * NCH + cg + k) * 128 + d];
#pragma unroll
            for (int k = 0; k < 11; ++k) {
                const int c = cg + k, sidx = sq * NCH + c;
                u32x4 w; w.x = pk2(carry[0], carry[1]); w.y = pk2(carry[2], carry[3]); w.z = pk2(carry[4], carry[5]); w.w = pk2(carry[6], carry[7]);
                *(u32x4*)(base + (size_t)c * 16384) = w;
                float al, be;
                if (type == 0) {
                    const float L = vec[c], bT = vec[64 + c]; const float mn = bT + fmaxf(m_in, L);
                    al = __expf(bT + m_in - mn); be = __expf(bT + L - mn);
                    if (quarter == 0 && tid == 0) MIN_[sidx] = m_in;
                    if (nthr) { NIN[sidx * 128 + tid] = ncar; ncar = al * ncar + be * aux[k]; }
                    m_in = mn;
                } else { al = __expf(aux[k]); be = 1.f; }
                const u32x4 u4 = uu[k];
                carry[0] = al * carry[0] + be * bflo(u4.x); carry[1] = al * carry[1] + be * bfhi(u4.x);
                carry[2] = al * carry[2] + be * bflo(u4.y); carry[3] = al * carry[3] + be * bfhi(u4.y);
                carry[4] = al * carry[4] + be * bflo(u4.z); carry[5] = al * carry[5] + be * bfhi(u4.z);
                carry[6] = al * carry[6] + be * bflo(u4.w); carry[7] = al * carry[7] + be * bfhi(u4.w);
            }
        }
        float* o = outp + (type ? O_SP : O_CP) + (size_t)sq * 16384 + eo;
        *(f32x4*)o = (f32x4){carry[0], carry[1], carry[2], carry[3]}; *(f32x4*)(o + 4) = (f32x4){carry[4], carry[5], carry[6], carry[7]};
        if (nthr) outp[O_NP + sq * 128 + tid] = ncar;
        if (type == 0 && quarter == 0 && tid == 0) outp[O_MPR + sq] = m_in;
    } }
    GSYNC();
    if (DBG_STOP == 3) { DG(WS_CSTM, SZ_CST, true); DG(WS_CSTH, SZ_CST, false); DG(WS_SMALL + SM_MIN, NSLOT * 4, false); DG(WS_SMALL + SM_NIN, NSLOT * 512, false); return; }

    { unsigned char* const ws = KWS(); float* const outp = KOUT(); const float* lbl = KIN(15);
      const float* stC = KIN(2); const float* stN = KIN(3); const float* stM = KIN(4); const float* stS = KIN(5); const float* gna = KIN(13); const float* gnb = KIN(14);
#define P4_DECODE(it_) do { const int it__ = (it_); n_sidx = 0; n_sb = 0; n_sample = false; \
        if (it__ < 2 * NSLOT) { n_type = it__ / NSLOT; const int j = it__ - n_type * NSLOT, b = j / 132, rem = j - b * 132; n_h = rem / NCH; const int c = rem - n_h * NCH; \
            n_len = c ? 64 : NMETA; n_r0 = b * TP + (c ? NMETA + (c - 1) * 64 : 0); n_sidx = j; } \
        else { const int j = it__ - 2 * NSLOT; n_type = j >> 9; const int rem = j & 511; n_sb = rem >> 2; n_h = rem & 3; n_len = DS; n_r0 = RP + n_sb * DS; n_sample = true; } } while (0)
#define P4_ISSUE() do { \
        chunk_ld(rq, (const bf16_t*)(ws + WS_QAB) + (size_t)n_r0 * 1024 + n_type * 512 + n_h * 128, 1024, n_len, tid); \
        chunk_ld(rv, (const bf16_t*)(ws + (n_type ? WS_IB : WS_VA)) + (size_t)n_r0 * 512 + n_h * 128, 512, n_len, tid); \
        if (n_type == 0) { u32x4 rk_[2]; chunk_ld(rk_, (const bf16_t*)(ws + WS_KA) + (size_t)n_r0 * 512 + n_h * 128, 512, n_len, tid); fbv[0] = __builtin_bit_cast(f32x4, rk_[0]); fbv[1] = __builtin_bit_cast(f32x4, rk_[1]); } \
        else fb_ld(fbv, (const float*)(ws + WS_FB) + (size_t)n_r0 * 512 + n_h * 128, n_len, tid); \
        if (!n_sample) { const bf16_t* cs = (const bf16_t*)(ws + (n_type ? WS_CSTH : WS_CSTM)) + (size_t)n_sidx * 16384; \
            _Pragma("unroll") for (int i = 0; i < 4; ++i) { const int q = tid + i * 512, d = q >> 4, cc = q & 15; cst[i] = *(const f32x4*)(cs + d * 128 + cc * 8); } } \
        if (n_type == 0) { \
            if (wave == 0) { const bool valid_ = lane < n_len; pg_a = valid_ ? IG[(n_r0 + lane) * 4 + n_h] : 0.f; pg_b = valid_ ? LFA[(n_r0 + lane) * 4 + n_h] : 0.f; \
                pg_m = n_sample ? stM[n_sb * 4 + n_h] : MIN_[n_sidx]; } \
            else if (wave == 2 || wave == 3) { const int d_ = tid - 128; pg_a = n_sample ? stN[(n_sb * 4 + n_h) * 128 + d_] : NIN[n_sidx * 128 + d_]; } } \
        } while (0)
    u32x4 rq[2], rv[2]; f32x4 cst[4]; f32x4 fbv[4];
    float pg_a = 0.f, pg_b = 0.f, pg_m = 0.f;
    __syncthreads();
    { LAS float* gl = (LAS float*)(lds + LGN); gl[tid] = gna[tid]; gl[512 + tid] = gnb[tid]; }
    int n_type = 0, n_h = 0, n_len = 0, n_r0 = 0, n_sidx = 0, n_sb = 0; bool n_sample = false;
    constexpr int P4N = 2 * NSLOT + 1024;
    if (bx < P4N) { P4_DECODE(bx); P4_ISSUE(); }
    for (int item = bx; item < P4N; item += G) {
        const int type = n_type, h = n_h, len = n_len, r0 = n_r0, sidx = n_sidx, sb = n_sb; const bool sample = n_sample;
        const float* Csrc = (type ? stS : stC) + (size_t)(sb * 4 + h) * 16384;
        __syncthreads();
        u32x4 rg[2]; chunk_ld(rg, (const bf16_t*)(ws + (type ? WS_GB : WS_OA)) + (size_t)r0 * 512 + h * 128, 512, len, tid);
        chunk_st(lds + LQ, rq, tid); chunk_st(lds + LV, rv, tid);
        if (type == 0) { u32x4 rk_[2]; rk_[0] = __builtin_bit_cast(u32x4, fbv[0]); rk_[1] = __builtin_bit_cast(u32x4, fbv[1]); chunk_st(lds + LK, rk_, tid); }
        if (!sample) {
#pragma unroll
            for (int i = 0; i < 4; ++i) { const int q = tid + i * 512, d = q >> 4, cc = q & 15; *(LAS f32x4*)(lds + LC + d * RSTR + cc * 16) = cst[i]; }
        } else {
            f32x4 sst[8];
#pragma unroll
            for (int i = 0; i < 8; ++i) { const int q = tid + i * 512, d = q >> 5, c4 = q & 31; sst[i] = *(const f32x4*)(Csrc + d * 128 + c4 * 4); }
#pragma unroll
            for (int i = 0; i < 8; ++i) { const int q = tid + i * 512, d = q >> 5, c4 = q & 31; const f32x4 v = sst[i];
                u32x2 w; w.x = pk2(v.x, v.y); w.y = pk2(v.z, v.w); *(LAS u32x2*)(lds + LC + d * RSTR + c4 * 8) = w; }
        }
        if (tid < 64) { vec[V_DENI + tid] = 0.f; vec[V_SSQ + tid] = 0.f; }
        if (type == 0) {
            if (wave == 0) {
                const bool valid = lane < len;
                const float m_in = pg_m;
                const float ig = pg_a; float bc = pg_b;
#pragma unroll
                for (int o = 1; o < 64; o <<= 1) { const float t = __shfl_up(bc, o); if (lane >= o) bc += t; }
                const float a = valid ? ig - bc : -INFINITY; float mx = a;
#pragma unroll
                for (int o = 1; o < 64; o <<= 1) { const float t = __shfl_up(mx, o); if (lane >= o) mx = fmaxf(mx, t); }
                const float mt = bc + fmaxf(m_in, mx);
                vec[V_BM + lane] = bc - mt; vec[V_AV + lane] = a; vec[V_DEC + lane] = __expf(bc + m_in - mt); vec[V_EM + lane] = __expf(-mt);
                const float bmT = __shfl(bc - mt, len - 1);
                vec[V_WT + lane] = valid ? __expf(bmT + a) : 0.f;
                if (sample && lane == len - 1) outp[O_MS + sb * 4 + h] = mt;
            } else if (wave == 2 || wave == 3) {
                const int d = tid - 128;
                vec[V_NIN + d] = pg_a;
            }
            __syncthreads();
        } else {
            hgrn_prep(lds, fbv, lbl, h, len, tid);
            LAS float* A = (LAS float*)(lds + LA);
            const int cch = tid & 127, part = tid >> 7;
            { const int c4 = tid & 31, sr = tid >> 5;
#pragma unroll
              for (int jj = 0; jj < 4; ++jj) { const int s = sr + 16 * jj;
                const f32x4 a4 = *(const LAS f32x4*)(A + s * 128 + c4 * 4);
                LAS u32x2* kp = (LAS u32x2*)(lds + LK + s * RSTR + c4 * 8); const u32x2 kw = *kp;
                LAS u32x2* qp = (LAS u32x2*)(lds + LQ + s * RSTR + c4 * 8); const u32x2 qw = *qp;
                const f32x4 k4 = exp4(-a4) * (f32x4){bflo(kw.x), bfhi(kw.x), bflo(kw.y), bfhi(kw.y)};
                const f32x4 q4 = exp4(a4) * (f32x4){bflo(qw.x), bfhi(qw.x), bflo(qw.y), bfhi(qw.y)};
                u32x2 ok; ok.x = pk2(k4[0], k4[1]); ok.y = pk2(k4[2], k4[3]); *kp = ok;
                u32x2 oq; oq.x = pk2(q4[0], q4[1]); oq.y = pk2(q4[2], q4[3]); *qp = oq; } }
            __syncthreads();
        }
        if (type == 0) {
            const int t = tid >> 3, part = tid & 7; float s = 0.f;
            const LAS u32x4* qp = (const LAS u32x4*)(lds + LQ + t * RSTR + part * 32); const LAS f32x4* np = (const LAS f32x4*)(vec + V_NIN + part * 16);
#pragma unroll
            for (int i = 0; i < 2; ++i) { const u32x4 qw = qp[i]; const f32x4 n0 = np[2 * i], n1 = np[2 * i + 1];
                s += (bflo(qw.x) * n0[0] + bfhi(qw.x) * n0[1]) + (bflo(qw.y) * n0[2] + bfhi(qw.y) * n0[3]) + (bflo(qw.z) * n1[0] + bfhi(qw.z) * n1[1]) + (bflo(qw.w) * n1[2] + bfhi(qw.w) * n1[3]); }
            s += __shfl_xor(s, 1); s += __shfl_xor(s, 2); s += __shfl_xor(s, 4);
            if (part == 0) vec[V_DENQ + t] = s * vec[V_DEC + t];
        }
        chunk_st(lds + LG, rg, tid);
        {
            const int t0 = 16 * (wave & 3), tt = t0 + (lane & 15);
            bf16x8 qf[4];
#pragma unroll
            for (int k = 0; k < 4; ++k) qf[k] = rowfrag(lds + LQ, RSTR, t0, 32 * k, lane);
            const float bmt = (type == 0) ? vec[V_BM + tt] : 0.f;
            float rsum = 0.f;
#pragma unroll
            for (int si = 0; si < 2; ++si) {
                const int s0 = 16 * ((wave >> 2) * 2 + si);
                f32x4 acc = (f32x4){0.f, 0.f, 0.f, 0.f};
#pragma unroll
                for (int k = 0; k < 4; ++k) acc = __builtin_amdgcn_mfma_f32_16x16x32_bf16(rowfrag(lds + LK, RSTR, s0, 32 * k, lane), qf[k], acc, 0, 0, 0);
                float sw[4];
#pragma unroll
                for (int jj = 0; jj < 4; ++jj) { const int s = s0 + 4 * (lane >> 4) + jj; const bool ok = (s <= tt) && (s < len);
                    float w = 1.f; if (type == 0) w = __expf(bmt + (ok ? vec[V_AV + s] : 0.f));
                    sw[jj] = ok ? acc[jj] * w : 0.f; rsum += sw[jj]; }
                u32x2 w2; w2.x = pk2(sw[0], sw[1]); w2.y = pk2(sw[2], sw[3]);
                *(LAS u32x2*)(lds + LSW + tt * SWSTR + (s0 + 4 * (lane >> 4)) * 2) = w2;
            }
            if (type == 0) { rsum += __shfl_xor(rsum, 16); rsum += __shfl_xor(rsum, 32); if (lane < 16) atomicAdd((float*)(vec + V_DENI + tt), rsum); }
        }
        __syncthreads();
        { const int nxi = item + G; if (nxi < P4N) { P4_DECODE(nxi); P4_ISSUE(); } }
        {
            const int t0 = 16 * (wave & 3), tt = t0 + (lane & 15);
            bf16x8 qf[4], sf[2];
#pragma unroll
            for (int k = 0; k < 4; ++k) qf[k] = rowfrag(lds + LQ, RSTR, t0, 32 * k, lane);
#pragma unroll
            for (int k = 0; k < 2; ++k) sf[k] = rowfrag(lds + LSW, SWSTR, t0, 32 * k, lane);
            float dect = 1.f, rden = 1.f;
            if (type == 0) { dect = vec[V_DEC + tt]; const float den = vec[V_DENQ + tt] + vec[V_DENI + tt]; rden = frcp(fmaxf(fabsf(den), vec[V_EM + tt])); }
            f32x4 hv[4]; float ss = 0.f;
#pragma unroll
            for (int ei = 0; ei < 4; ++ei) {
                const int e0 = 16 * ((wave >> 2) * 4 + ei);
                f32x4 a1 = (f32x4){0.f, 0.f, 0.f, 0.f}, a2 = a1;
#pragma unroll
                for (int k = 0; k < 4; ++k) a1 = __builtin_amdgcn_mfma_f32_16x16x32_bf16(trfrag(lds + LC, RSTR, 32 * k, e0, lane), qf[k], a1, 0, 0, 0);
#pragma unroll
                for (int k = 0; k < 2; ++k) a2 = __builtin_amdgcn_mfma_f32_16x16x32_bf16(trfrag(lds + LV, RSTR, 32 * k, e0, lane), sf[k], a2, 0, 0, 0);
                hv[ei] = (a1 * dect + a2) * rden;
                ss += (hv[ei][0] * hv[ei][0] + hv[ei][1] * hv[ei][1]) + (hv[ei][2] * hv[ei][2] + hv[ei][3] * hv[ei][3]);
            }
            ss += __shfl_xor(ss, 16); ss += __shfl_xor(ss, 32);
            if (lane < 16) atomicAdd((float*)(vec + V_SSQ + tt), ss);
            __syncthreads();
            const float rs = rsqrtf(vec[V_SSQ + tt] * (1.0f / 128.0f) + RMS_EPS);
            if (tt < len) {
                const LAS float* gn = (const LAS float*)(lds + LGN) + type * 512 + h * 128;
                bf16_t* dst = (bf16_t*)(ws + WS_QAB) + (size_t)(r0 + tt) * 1024 + type * 512 + h * 128;
#pragma unroll
                for (int ei = 0; ei < 4; ++ei) {
                    const int e = 16 * ((wave >> 2) * 4 + ei) + 4 * (lane >> 4);
                    const u32x2 gt = *(const LAS u32x2*)(lds + LG + tt * RSTR + e * 2); const f32x4 g4 = *(const LAS f32x4*)(gn + e);
                    const f32x4 o = hv[ei] * rs * g4 * (f32x4){bflo(gt.x), bfhi(gt.x), bflo(gt.y), bfhi(gt.y)};
                    u32x2 w; w.x = pk2(o[0], o[1]); w.y = pk2(o[2], o[3]); *(u32x2*)(dst + e) = w;
                }
            }
        }
        if (sample) {
            const int e4 = tid & 31, dg = tid >> 5;
            LAS float* A = (LAS float*)(lds + LA);
            f32x4 vv[DS];
#pragma unroll
            for (int s = 0; s < DS; ++s) { const u32x2 t = *(const LAS u32x2*)(lds + LV + s * RSTR + e4 * 8); const float w = (type == 0) ? vec[V_WT + s] : 1.f;
                vv[s] = (f32x4){bflo(t.x), bfhi(t.x), bflo(t.y), bfhi(t.y)} * w; }
            const float decT = (type == 0) ? vec[V_DEC + DS - 1] : 1.f;
            float* od = outp + (type ? O_SS : O_CS) + (size_t)(sb * 4 + h) * 16384;
#pragma unroll 2
            for (int i = 0; i < 8; ++i) { const int d = dg + 16 * i;
                const float rsc = (type == 0) ? decT : __expf(A[(DS - 1) * 128 + d]); const float ksc = (type == 0) ? 1.f : rsc;
                f32x4 o = *(const f32x4*)(Csrc + d * 128 + e4 * 4) * rsc;
#pragma unroll
                for (int s = 0; s < DS; ++s) o += vv[s] * (ksc * bf2f(*(const LAS bf16_t*)(lds + LK + s * RSTR + d * 2)));
                *(f32x4*)(od + d * 128 + e4 * 4) = o; }
            if (type == 0 && tid < 128) { float n = decT * vec[V_NIN + tid];
#pragma unroll
                for (int s = 0; s < DS; ++s) n += vec[V_WT + s] * bf2f(*(const LAS bf16_t*)(lds + LK + s * RSTR + tid * 2));
                outp[O_NS + (sb * 4 + h) * 128 + tid] = n; }
        }
    } }
    GSYNC();
    if (DBG_STOP == 4) { DG(WS_QAB, SZ_R1024, true); return; }

    {
        unsigned char* const ws = KWS();
        pg8::Gemm g{(const bf16_t*)(ws + WS_QAB), (const bf16_t*)(ws + WS_WOUT), MP, 1024, 1024}; pg8::TailSplitOrder S; S.init(MP, 1024, G, bx, 1024, 8);
        pg8::EpiZ1 E{KIN(0), KIN(1), KIN(7), KIN(8), KIN(9), KIN(17), stats, (float*)(ws + WS_Z1), KOUT(), S.tail_row0()};
        pg8::gemm_phase<pg8::EpiZ1, pg8::TailSplitOrder, true, true>(lds, g, S, E);
    }
    GSYNC();
    if (DBG_STOP == 5) { DG(WS_Z1, 2 * SZ_R1024, true); return; }
    {
        unsigned char* const ws = KWS();
        const int gw = bx * 8 + wave, NGW = G * 8;
        const float* z1 = (const float*)(ws + WS_Z1); bf16_t* X1B = (bf16_t*)(ws + WS_X1B);
        pg8::TailSplitOrder S5; S5.init(MP, 1024, G, bx, 1024, 8); const int tr0 = S5.tail_row0(); const float* ztail = KOUT();
        const float* lg = KIN(18); const float* lb = KIN(19);
#define Z1ROW(r_) ((const f32x4*)((r_) >= tr0 ? ztail + (size_t)((r_) - tr0) * DM : z1 + (size_t)(r_) * DM) + lane)
        f32x4 nv[4];
        if (gw < MR) { const f32x4* xr = Z1ROW(gw);
#pragma unroll
            for (int j = 0; j < 4; ++j) nv[j] = xr[64 * j]; }
        for (int r = gw; r < MP; r += NGW) {
            unsigned long long* o8 = (unsigned long long*)(X1B + (size_t)r * DM) + lane;
            f32x4 v[4]; float s = 0.f;
#pragma unroll
            for (int j = 0; j < 4; ++j) v[j] = nv[j];
            if (r + NGW < MR) { const f32x4* xn = Z1ROW(r + NGW);
#pragma unroll
                for (int j = 0; j < 4; ++j) nv[j] = xn[64 * j]; }
            if (r >= MR) {
#pragma unroll
                for (int j = 0; j < 4; ++j) o8[64 * j] = 0ull;
                continue; }
            const f32x4* xr = Z1ROW(r);
            if (r >= tr0) for (int pc = 1; pc < 8; ++pc) {
#pragma unroll
                for (int j = 0; j < 4; ++j) v[j] += xr[pc * (pg8::PART_STRIDE / 4) + 64 * j]; }
#pragma unroll
            for (int j = 0; j < 4; ++j) s += (v[j].x + v[j].y) + (v[j].z + v[j].w);
            const float mean = wave_sum(s) * (1.f / DM); float s2 = 0.f;
#pragma unroll
            for (int j = 0; j < 4; ++j) { v[j] = v[j] - mean; s2 += (v[j].x * v[j].x + v[j].y * v[j].y) + (v[j].z * v[j].z + v[j].w * v[j].w); }
            const float rstd = 1.f / sqrtf(wave_sum(s2) * (1.f / DM) + LN_EPS);
#pragma unroll
            for (int j = 0; j < 4; ++j) {
                const f32x4 gg = *((const f32x4*)lg + lane + 64 * j), bb = *((const f32x4*)lb + lane + 64 * j);
                v[j] = v[j] * rstd * gg + bb;
                o8[64 * j] = (unsigned long long)pk2(v[j].x, v[j].y) | ((unsigned long long)pk2(v[j].z, v[j].w) << 32);
            }
        }
    }
    GSYNC();
    if (DBG_STOP == 6) { DG(WS_X1B, SZ_R1024, true); return; }
    {
        unsigned char* const ws = KWS();
        pg8::Gemm g{(const bf16_t*)(ws + WS_X1B), (const bf16_t*)(ws + WS_WUP), MP, DFF, 1024}; pg8::StaticOrder S; S.init(MP, DFF, G, bx);
        pg8::EpiU E{(bf16_t*)(ws + WS_U), KIN(21), KOUT()};
        pg8::gemm_phase<pg8::EpiU, pg8::StaticOrder, true, true>(lds, g, S, E);
    }
    GSYNC();
    if (DBG_STOP == 7) { DG(WS_U, SZ_U, true); return; }
    {
        unsigned char* const ws = KWS();
        pg8::Gemm g{(const bf16_t*)(ws + WS_X1B), (const bf16_t*)(ws + WS_WUP) + (size_t)DFF * 1024, MP, DFF, 1024}; pg8::StaticOrder S; S.init(MP, DFF, G, bx);
        pg8::EpiAct E{(const bf16_t*)(ws + WS_U), (bf16_t*)(ws + WS_ACT), KIN(21) + DFF, KIN(22), KIN(23), KIN(6)};
        pg8::gemm_phase<pg8::EpiAct, pg8::StaticOrder, true, true>(lds, g, S, E);
    }
    GSYNC();
    if (DBG_STOP == 8) { DG(WS_ACT, SZ_U, true); return; }
    {
        unsigned char* const ws = KWS();
        pg8::Gemm g{(const bf16_t*)(ws + WS_ACT), (const bf16_t*)(ws + WS_WDN), MP, 1024, DFF}; pg8::TailSplitOrder S; S.init(MP, 1024, G, bx, DFF, 11);
        pg8::EpiZ2 E{(const bf16_t*)(ws + WS_X1B), KIN(25), KOUT(), (float*)(ws + WS_U), S.tail_row0()};
        pg8::gemm_phase<pg8::EpiZ2, pg8::TailSplitOrder, true, true>(lds, g, S, E);
    }
    GSYNC();
    {
        const int gw = bx * 8 + wave, NGW = G * 8;
        const float* lg = KIN(26); const float* lb = KIN(27); float* const outp = KOUT();
        pg8::TailSplitOrder S7; S7.init(MP, 1024, G, bx, DFF, 11); const int ty0 = S7.split_mode ? S7.tail_row0() - 128 : (1 << 30);
        const float* part = (const float*)(KWS() + WS_U);
#define Z2ROW(r_) ((const f32x4*)((r_) >= ty0 ? part + (size_t)((r_) - ty0) * DM : outp + (size_t)(r_) * DM) + lane)
        f32x4 nv[4];
        if (gw < NB * SEQ + RS) { const f32x4* x0 = Z2ROW(gw);
#pragma unroll
            for (int j = 0; j < 4; ++j) nv[j] = x0[64 * j]; }
        for (int r = gw; r < NB * SEQ + RS; r += NGW) {
            f32x4* xr = (f32x4*)(outp + (size_t)r * DM) + lane;
            f32x4 v[4]; float s = 0.f;
#pragma unroll
            for (int j = 0; j < 4; ++j) v[j] = nv[j];
            if (r + NGW < NB * SEQ + RS) { const f32x4* xn = Z2ROW(r + NGW);
#pragma unroll
                for (int j = 0; j < 4; ++j) nv[j] = xn[64 * j]; }
            if (r >= ty0) {
                const f32x4* pr = Z2ROW(r);
                for (int pc = 1; pc < 11; ++pc) {
#pragma unroll
                    for (int j = 0; j < 4; ++j) v[j] += pr[pc * (pg8::PART_STRIDE / 4) + 64 * j]; }
            }
#pragma unroll
            for (int j = 0; j < 4; ++j) s += (v[j].x + v[j].y) + (v[j].z + v[j].w);
            const float mean = wave_sum(s) * (1.f / DM); float s2 = 0.f;
#pragma unroll
            for (int j = 0; j < 4; ++j) { v[j] = v[j] - mean; s2 += (v[j].x * v[j].x + v[j].y * v[j].y) + (v[j].z * v[j].z + v[j].w * v[j].w); }
            const float rstd = 1.f / sqrtf(wave_sum(s2) * (1.f / DM) + LN_EPS);
#pragma unroll
            for (int j = 0; j < 4; ++j) {
                const f32x4 gg = *((const f32x4*)lg + lane + 64 * j), bb = *((const f32x4*)lb + lane + 64 * j);
                xr[64 * j] = v[j] * rstd * gg + bb;
            }
        }
    }
}

extern "C" void kernel_launch(void* const* d_in, const int* in_sizes, int n_in, void* d_out, int out_size, void* d_ws, size_t ws_size, hipStream_t stream) {
    static int grid_blocks = 0;
    if (grid_blocks == 0) {
        int dev = 0, cus = 0, per_cu = 0;
        (void)hipGetDevice(&dev);
        (void)hipDeviceGetAttribute(&cus, hipDeviceAttributeMultiprocessorCount, dev);
        (void)hipFuncSetAttribute((const void*)fwd_kernel, hipFuncAttributeMaxDynamicSharedMemorySize, LDS_BYTES);
        (void)hipOccupancyMaxActiveBlocksPerMultiprocessor(&per_cu, (const void*)fwd_kernel, 512, LDS_BYTES);
        if (per_cu < 1) { fprintf(stderr, "kernel_launch: occupancy query returned %d\n", per_cu); per_cu = 1; }
        grid_blocks = cus * per_cu;
    }
    (void)hipMemsetAsync((unsigned char*)d_ws + WS_SMALL + SM_BAR, 0, 16384, stream);
    Params p{};
    for (int i = 0; i < 28; ++i) p.in[i] = (const float*)d_in[i];
    p.out = (float*)d_out; p.ws = (unsigned char*)d_ws;
    void* args[] = {&p};
    hipError_t e = hipLaunchCooperativeKernel((const void*)fwd_kernel, dim3(grid_blocks), dim3(512), args, LDS_BYTES, stream);
    if (e != hipSuccess) fprintf(stderr, "cooperative launch failed: %s (grid %d)\n", hipGetErrorString(e), grid_blocks);
}
```

```cpp
#include <hip/hip_runtime.h>
#include <hip/hip_cooperative_groups.h>
#include <cstdio>
#include <cstdint>
namespace cg = cooperative_groups;

#define LAS __attribute__((address_space(3)))
typedef unsigned short bf16_t;
typedef short bf16x8 __attribute__((ext_vector_type(8)));
typedef short s16x4 __attribute__((ext_vector_type(4)));
typedef float f32x4 __attribute__((ext_vector_type(4)));
typedef unsigned u32x4 __attribute__((ext_vector_type(4)));
typedef unsigned u32x2 __attribute__((ext_vector_type(2)));

constexpr int DM = 1024, NB = 8, SEQ = 2048, NMETA = 16, TP = SEQ + NMETA, DB = 128, DS = 8;
constexpr int RP = NB * TP;
constexpr int RS = DB * DS;
constexpr int MR = RP + RS;
constexpr int MP = 17664;
constexpr int DFF = 2816, DIN = 4104;
constexpr int NCH = 33;
constexpr int NSLOT = NB * 4 * NCH;
constexpr float ALPHA = 1.189207115002721f;
constexpr float LN_EPS = 1e-5f, RMS_EPS = 1e-6f;
constexpr float KSCALE = 0.08838834764831845f;

constexpr size_t MiB = 1u << 20;
constexpr size_t WS_WIN = 0, WS_WOUT = 8 * MiB, WS_WUP = 10 * MiB, WS_WDN = 21 * MiB;
constexpr size_t WS_SMALL = 27 * MiB;
constexpr size_t SM_STATS = 0;
constexpr size_t SM_IG = 160 * 1024;
constexpr size_t SM_LFA = SM_IG + 288 * 1024;
constexpr size_t SM_CHKL = SM_LFA + 288 * 1024;
constexpr size_t SM_CHKB = SM_CHKL + 8192;
constexpr size_t SM_MIN = SM_CHKB + 8192;
constexpr size_t SM_CHKN = SM_MIN + 8192;
constexpr size_t SM_NIN = SM_CHKN + 544 * 1024;
constexpr size_t SM_CHKA = SM_NIN + 544 * 1024;
constexpr size_t SM_BAR = SM_CHKA + 544 * 1024;
static_assert(SM_BAR + 16384 <= 4 * MiB, "small region");
constexpr size_t WS_BIG = 31 * MiB;
constexpr size_t SZ_R1024 = (size_t)MP * 1024 * 2;
constexpr size_t SZ_R512 = (size_t)MP * 512 * 2;
constexpr size_t SZ_CST = (size_t)NSLOT * 16384 * 2;
constexpr size_t WS_XN = WS_BIG, WS_CSTM = WS_BIG;
constexpr size_t WS_QAB = WS_BIG + SZ_R1024;
constexpr size_t WS_KA = WS_QAB + SZ_R1024, WS_VA = WS_KA + SZ_R512, WS_OA = WS_VA + SZ_R512, WS_IB = WS_OA + SZ_R512, WS_GB = WS_IB + SZ_R512;
constexpr size_t WS_FB = WS_GB + SZ_R512;
constexpr size_t WS_CSTH = WS_FB + SZ_R1024;
static_assert(WS_CSTH + SZ_CST <= 256 * MiB, "ws map (mixer)");
constexpr size_t WS_X1B = WS_BIG;
constexpr size_t WS_Z1 = WS_BIG + 2 * SZ_R1024;
constexpr size_t SZ_U = (size_t)MP * DFF * 2;
constexpr size_t WS_U = WS_BIG + SZ_R1024;
constexpr size_t WS_ACT = WS_U + SZ_U;
static_assert(WS_ACT + SZ_U <= 256 * MiB, "ws map (ffn)");

constexpr size_t O_YP = 0, O_CP = 17825792, O_NP = 18350080, O_MPR = 18354176, O_SP = 18354208, O_CVP = 18878496,
                 O_CS = 18923552, O_NS = 27312160, O_MS = 27377696, O_SS = 27378208, O_CVS = 35766816;

constexpr int LDS_BYTES = 155648;

struct Params { const float* in[28]; float* out; unsigned char* ws; };

typedef float f32x2_t __attribute__((ext_vector_type(2)));
typedef __bf16 bf16x2_t __attribute__((ext_vector_type(2)));
__device__ __forceinline__ unsigned pk2(float lo, float hi) { const f32x2_t v = {lo, hi}; const bf16x2_t b = __builtin_convertvector(v, bf16x2_t); return __builtin_bit_cast(unsigned, b); }
__device__ __forceinline__ unsigned f2bf(float f) { return pk2(f, 0.f) & 0xffffu; }
__device__ __forceinline__ float bflo(unsigned u) { return __uint_as_float(u << 16); }
__device__ __forceinline__ float bfhi(unsigned u) { return __uint_as_float(u & 0xffff0000u); }
__device__ __forceinline__ float bf2f(bf16_t h) { return __uint_as_float(((unsigned)h) << 16); }
__device__ __forceinline__ float wave_sum(float v) {
#pragma unroll
    for (int o = 1; o < 64; o <<= 1) v += __shfl_xor(v, o);
    return v;
}
__device__ __forceinline__ float frcp(float x) { return __builtin_amdgcn_rcpf(x); }
__device__ __forceinline__ float sigmoidf_(float x) { return frcp(1.0f + __expf(-x)); }
__device__ __forceinline__ float siluf_(float x) { return x * frcp(1.0f + __expf(-x)); }
__device__ __forceinline__ f32x4 exp4(const f32x4 x) {
    const f32x4 t = x * 1.4426950408889634f;
    f32x4 e; e[0] = __builtin_amdgcn_exp2f(t[0]); e[1] = __builtin_amdgcn_exp2f(t[1]); e[2] = __builtin_amdgcn_exp2f(t[2]); e[3] = __builtin_amdgcn_exp2f(t[3]);
    return e;
}
__device__ __forceinline__ f32x4 sigmoid4(const f32x4 x) {
    const f32x4 t = x * (-1.4426950408889634f);
    f32x4 e; e[0] = __builtin_amdgcn_exp2f(t[0]); e[1] = __builtin_amdgcn_exp2f(t[1]); e[2] = __builtin_amdgcn_exp2f(t[2]); e[3] = __builtin_amdgcn_exp2f(t[3]);
    const f32x4 d = e + 1.0f;
    f32x4 r; r[0] = __builtin_amdgcn_rcpf(d[0]); r[1] = __builtin_amdgcn_rcpf(d[1]); r[2] = __builtin_amdgcn_rcpf(d[2]); r[3] = __builtin_amdgcn_rcpf(d[3]);
    return r;
}
__device__ __forceinline__ const float* xrow_ptr(const float* xp, const float* xs, const float* meta, int r) {
    if (r < RP) { const int b = r / TP, q = r - b * TP; return q < NMETA ? meta + (size_t)q * DM : xp + ((size_t)b * SEQ + (q - NMETA)) * DM; }
    return xs + (size_t)(r - RP) * DM;
}
typedef __attribute__((address_space(4))) const Params* KP;
__device__ __forceinline__ KP kparams() { KP k = (KP)__builtin_amdgcn_kernarg_segment_ptr(); asm volatile("" : "+s"(k)); return k; }
#define KIN(i) (kparams()->in[i])
#define KOUT() (kparams()->out)
#define KWS() (kparams()->ws)

namespace pg8 {
constexpr int BM = 256, BK = 64, HALF = 128, HTB = HALF * BK * 2, STAGE_BYTES = 8 * HTB, NXCD = 8, WGM = 8;
__host__ __device__ __forceinline__ int lds_byte(int r, int c) { const int st = (r >> 4) * 2 + (c >> 5), rr = r & 15, cc = c & 31, ob = rr * 64 + cc * 2; return st * 1024 + (ob ^ (((ob >> 9) & 1) << 5)); }
__host__ __device__ __forceinline__ void stage_rc(int b, int& R, int& C) { const int st = b / 1024, sb = b % 1024, swz = sb ^ (((sb >> 9) & 1) << 5); R = (st >> 1) * 16 + swz / 64; C = (st & 1) * 32 + (swz % 64) / 2; }
__host__ __device__ __forceinline__ int perm32(int rho) { const int n = rho >> 4, i = rho & 15; return 8 * (i >> 2) + 4 * n + (i & 3); }
struct Unit { int pm, pn, k0, nk, split; };
struct Gemm { const bf16_t* A; const bf16_t* Bt; int M, N, K; };
struct StaticOrder {
    int nM, nN, nwg, G, c, ntk;
    __host__ __device__ void init(int M, int N, int G_, int c_, int K_ = 1024) { nM = M / BM; nN = N / BM; nwg = nM * nN; G = G_; c = c_; ntk = K_ / BK; }
    __host__ __device__ bool next(int i, Unit& u) const {
        u.k0 = 0; u.nk = ntk; u.split = 0;
        const long L = (long)i * G + c; if (L >= nwg) return false;
        int wgid = (int)L; { const int q = nwg / NXCD, r = nwg % NXCD, xcd = wgid % NXCD, off = wgid / NXCD; wgid = (xcd < r ? xcd * (q + 1) : r * (q + 1) + (xcd - r) * q) + off; }
        const int nig = WGM * nN, gid = wgid / nig, fm = gid * WGM, gsz = (nM - fm) < WGM ? (nM - fm) : WGM;
        u.pm = fm + ((wgid % nig) % gsz); u.pn = (wgid % nig) / gsz; return true;
    }
    __device__ __forceinline__ void a_ready(const Unit&) const {}
    __device__ __forceinline__ void done(const Unit&) const {}
};
__host__ __device__ __forceinline__ void map_unit(int wgid, int nM, int nN, int nwg, Unit& u) {
    { const int q = nwg / NXCD, r = nwg % NXCD, xcd = wgid % NXCD, off = wgid / NXCD; wgid = (xcd < r ? xcd * (q + 1) : r * (q + 1) + (xcd - r) * q) + off; }
    const int nig = WGM * nN, gid = wgid / nig, fm = gid * WGM, gsz = (nM - fm) < WGM ? (nM - fm) : WGM;
    u.pm = fm + ((wgid % nig) % gsz); u.pn = (wgid % nig) / gsz;
}
struct TailSplitOrder {
    int nM, nN, nwg, G, c, ntk, S, split_mode, nMf;
    __host__ __device__ __forceinline__ void init(int M, int N, int G_, int c_, int K_, int S_) {
        nM = M / BM; nN = N / BM; nwg = nM * nN; G = G_; c = c_; ntk = K_ / BK; S = S_; nMf = G_ / nN;
        const int R = nwg - G_;
        split_mode = (G_ % nN == 0) && R > 0 && R * S_ <= G_ && (ntk % (2 * S_) == 0);
    }
    __host__ __device__ __forceinline__ int tail_row0() const { return split_mode ? nMf * BM : (1 << 30); }
    __host__ __device__ __forceinline__ bool next(int i, Unit& u) const {
        u.k0 = 0; u.nk = ntk; u.split = 0;
        if (!split_mode) { const long L = (long)i * G + c; if (L >= nwg) return false; map_unit((int)L, nM, nN, nwg, u); return true; }
        if (i == 0) { map_unit(c, nMf, nN, G, u); return true; }
        if (i > 1) return false;
        const int R = nwg - G; if (c >= R * S) return false;
        const int t = c / S, piece = c - t * S;
        u.pm = nMf + t / nN; u.pn = t % nN; u.nk = ntk / S; u.k0 = piece * u.nk; u.split = piece + 1; return true;
    }
    __device__ __forceinline__ void a_ready(const Unit&) const {}
    __device__ __forceinline__ void done(const Unit&) const {}
};
__device__ __forceinline__ void atomic_add4(float* o, const f32x4 v) {
#pragma unroll
    for (int j = 0; j < 4; ++j) __hip_atomic_fetch_add(o + j, v[j], __ATOMIC_RELAXED, __HIP_MEMORY_SCOPE_AGENT);
}
__device__ __forceinline__ unsigned cvt_pk_bf16(float lo, float hi) { unsigned r; asm volatile("v_cvt_pk_bf16_f32 %0, %1, %2" : "=v"(r) : "v"(lo), "v"(hi)); return r; }

template <class Epi, class Sched, bool ALIGN_EPI = false, bool SP2 = false>
__device__ __forceinline__ void gemm_phase(LAS unsigned char* lds, const Gemm g, const Sched& S, const Epi& E) {
    int tid_l = threadIdx.x; asm volatile("" : "+v"(tid_l));
    const int tid = tid_l, wid = __builtin_amdgcn_readfirstlane(tid >> 6), lane = tid & 63, wr = wid >> 2, wc = wid & 3, fr = lane & 15, fq = lane >> 4;
    const int K = g.K;
    unsigned voffA[2], voffB[2];
#pragma unroll
    for (int i = 0; i < 2; ++i) { int R, C; stage_rc(tid * 16 + i * 8192, R, C); const int Rb = Epi::PERM ? ((R & ~31) + perm32(R & 31)) : R;
        voffA[i] = (unsigned)(R * K + C) * 2u; voffB[i] = (unsigned)(Rb * K + C) * 2u; }
    const size_t kstep = (size_t)(BK * 2);
    const size_t hstep = (size_t)HALF * K * 2;
    const size_t tstep = 2 * hstep;
    const unsigned ldsw = (unsigned)wid * 1024u;
    const int aoff = lds_byte(wr * 64 + fr, fq * 8), boff = lds_byte(wc * 32 + fr, fq * 8);
#define PG8_SA(b, h) (((b) * 2 + (h)) * HTB)
#define PG8_SB(b, h) ((4 + (b) * 2 + (h)) * HTB)
#define PG8_STAGE(bufoff, gbase, voff) do { _Pragma("unroll") for (int _i = 0; _i < 2; ++_i) \
        __builtin_amdgcn_global_load_lds((const unsigned*)((const char*)(gbase) + (voff)[_i]), (LAS unsigned*)(lds + (bufoff) + ldsw + _i * 8192), 16, 0, 0); } while (0)
#define PG8_LDA(dst, b, h) do { _Pragma("unroll") for (int m = 0; m < 4; ++m) _Pragma("unroll") for (int k = 0; k < 2; ++k) dst[m][k] = *(const LAS bf16x8*)(lds + PG8_SA(b, h) + aoff + m * 2048 + k * 1024); } while (0)
#define PG8_LDB(dst, b, h) do { _Pragma("unroll") for (int n = 0; n < 2; ++n) _Pragma("unroll") for (int k = 0; k < 2; ++k) dst[n][k] = *(const LAS bf16x8*)(lds + PG8_SB(b, h) + boff + n * 2048 + k * 1024); } while (0)
#define PG8_MMA(ai, bj, At, Bt) do { __builtin_amdgcn_s_setprio(1); _Pragma("unroll") for (int m = 0; m < 4; ++m) _Pragma("unroll") for (int n = 0; n < 2; ++n) _Pragma("unroll") for (int k = 0; k < 2; ++k) \
        acc[ai][bj][m][n] = __builtin_amdgcn_mfma_f32_16x16x32_bf16(Bt[n][k], At[m][k], acc[ai][bj][m][n], 0, 0, 0); __builtin_amdgcn_s_setprio(0); } while (0)
#define PG8_WAIT_V(n) asm volatile("s_waitcnt vmcnt(" #n ")" ::: "memory")
#define PG8_WAIT_L(n) asm volatile("s_waitcnt lgkmcnt(" #n ")" ::: "memory")
#define PG8_BAR __builtin_amdgcn_s_barrier()
#define PG8_SCHED __builtin_amdgcn_sched_barrier(0)
    Unit cur, nxt; int ui = 0;
    if (!S.next(0, cur)) return;
    f32x4 acc[2][2][4][2];
#pragma unroll
    for (int a = 0; a < 2; ++a)
#pragma unroll
        for (int b = 0; b < 2; ++b)
#pragma unroll
            for (int m = 0; m < 4; ++m)
#pragma unroll
                for (int n = 0; n < 2; ++n) acc[a][b][m][n] = (f32x4){0.f, 0.f, 0.f, 0.f};
    bf16x8 At[4][2], B0[2][2], B1[2][2];
    const char* cA = (const char*)g.A + (size_t)cur.pm * tstep + (size_t)cur.k0 * kstep; const char* cB = (const char*)g.Bt + (size_t)cur.pn * tstep + (size_t)cur.k0 * kstep;
    S.a_ready(cur);
    if constexpr (SP2) {
        PG8_STAGE(PG8_SB(0, 0), cB, voffB); PG8_STAGE(PG8_SB(0, 1), cB + hstep, voffB); PG8_STAGE(PG8_SA(0, 0), cA, voffA); PG8_STAGE(PG8_SA(0, 1), cA + hstep, voffA);
        if (wr == 1) PG8_BAR;
        PG8_WAIT_V(2); PG8_BAR;
        PG8_STAGE(PG8_SB(1, 0), cB + kstep, voffB); PG8_STAGE(PG8_SA(1, 0), cA + kstep, voffA); PG8_STAGE(PG8_SB(1, 1), cB + hstep + kstep, voffB);
        PG8_WAIT_V(6); PG8_BAR;
    } else {
        PG8_STAGE(PG8_SB(0, 0), cB, voffB); PG8_STAGE(PG8_SA(0, 0), cA, voffA); PG8_STAGE(PG8_SB(0, 1), cB + hstep, voffB); PG8_STAGE(PG8_SA(0, 1), cA + hstep, voffA);
        if (wr == 1) PG8_BAR;
        PG8_WAIT_V(4); PG8_BAR;
        PG8_STAGE(PG8_SB(1, 0), cB + kstep, voffB); PG8_STAGE(PG8_SA(1, 0), cA + kstep, voffA); PG8_STAGE(PG8_SB(1, 1), cB + hstep + kstep, voffB);
        PG8_WAIT_V(6); PG8_BAR;
    }
    for (;;) {
        const bool has_next = S.next(ui + 1, nxt);
        const char* nA = has_next ? (const char*)g.A + (size_t)nxt.pm * tstep + (size_t)nxt.k0 * kstep : cA; const char* nB = has_next ? (const char*)g.Bt + (size_t)nxt.pn * tstep + (size_t)nxt.k0 * kstep : cB;
        const int nt = cur.nk;
        for (int t = 0; t < nt; t += 2) {
            const bool last = (t == nt - 2);
            const char* a1 = cA + (size_t)(t + 1) * kstep;
            const char* a2 = last ? nA : cA + (size_t)(t + 2) * kstep; const char* b2 = last ? nB : cB + (size_t)(t + 2) * kstep;
            const char* a3 = a2 + kstep; const char* b3 = b2 + kstep;
            if (last && has_next) S.a_ready(nxt);
            if constexpr (SP2) {
            PG8_LDB(B0, 0, 0); PG8_LDB(B1, 0, 1); PG8_SCHED; PG8_LDA(At, 0, 0); PG8_STAGE(PG8_SA(1, 1), a1 + hstep, voffA);
            PG8_WAIT_V(8); PG8_WAIT_L(0); PG8_BAR; PG8_MMA(0, 0, At, B0); PG8_MMA(0, 1, At, B1); PG8_BAR; PG8_SCHED;
            PG8_LDA(At, 0, 1); PG8_STAGE(PG8_SB(0, 0), b2, voffB); PG8_STAGE(PG8_SB(0, 1), b2 + hstep, voffB); PG8_STAGE(PG8_SA(0, 0), a2, voffA);
            PG8_WAIT_V(8); PG8_WAIT_L(0); PG8_BAR; PG8_MMA(1, 0, At, B0); PG8_MMA(1, 1, At, B1); PG8_BAR; PG8_SCHED;
            PG8_LDB(B0, 1, 0); PG8_LDB(B1, 1, 1); PG8_SCHED; PG8_LDA(At, 1, 0); PG8_STAGE(PG8_SA(0, 1), a2 + hstep, voffA);
            PG8_WAIT_V(8); PG8_WAIT_L(0); PG8_BAR; PG8_MMA(0, 0, At, B0); PG8_MMA(0, 1, At, B1); PG8_BAR; PG8_SCHED;
            PG8_LDA(At, 1, 1); PG8_STAGE(PG8_SB(1, 0), b3, voffB); PG8_STAGE(PG8_SB(1, 1), b3 + hstep, voffB); PG8_STAGE(PG8_SA(1, 0), a3, voffA);
            PG8_WAIT_V(8); PG8_WAIT_L(0); PG8_BAR; PG8_MMA(1, 0, At, B0); PG8_MMA(1, 1, At, B1); PG8_BAR; PG8_SCHED;
            } else {
            PG8_LDB(B0, 0, 0); PG8_SCHED; PG8_LDA(At, 0, 0); PG8_STAGE(PG8_SA(1, 1), a1 + hstep, voffA);
            PG8_WAIT_L(8); PG8_BAR; PG8_WAIT_L(0); PG8_MMA(0, 0, At, B0); PG8_BAR; PG8_SCHED;
            PG8_LDB(B1, 0, 1); PG8_STAGE(PG8_SB(0, 0), b2, voffB);
            PG8_BAR; PG8_WAIT_L(0); PG8_MMA(0, 1, At, B1); PG8_BAR;
            PG8_LDA(At, 0, 1); PG8_STAGE(PG8_SA(0, 0), a2, voffA);
            PG8_BAR; PG8_WAIT_L(0); PG8_MMA(1, 0, At, B0); PG8_BAR; PG8_SCHED;
            PG8_STAGE(PG8_SB(0, 1), b2 + hstep, voffB);
            PG8_WAIT_V(6); PG8_BAR; PG8_MMA(1, 1, At, B1); PG8_BAR;
            PG8_LDB(B0, 1, 0); PG8_SCHED; PG8_LDA(At, 1, 0); PG8_STAGE(PG8_SA(0, 1), a2 + hstep, voffA);
            PG8_WAIT_L(8); PG8_BAR; PG8_WAIT_L(0); PG8_MMA(0, 0, At, B0); PG8_BAR; PG8_SCHED;
            PG8_LDB(B1, 1, 1); PG8_STAGE(PG8_SB(1, 0), b3, voffB);
            PG8_BAR; PG8_WAIT_L(0); PG8_MMA(0, 1, At, B1); PG8_BAR;
            PG8_LDA(At, 1, 1); PG8_STAGE(PG8_SA(1, 0), a3, voffA);
            PG8_BAR; PG8_WAIT_L(0); PG8_MMA(1, 0, At, B0); PG8_BAR; PG8_SCHED;
            PG8_STAGE(PG8_SB(1, 1), b3 + hstep, voffB);
            PG8_WAIT_V(6); PG8_BAR; PG8_MMA(1, 1, At, B1); PG8_BAR;
            }
        }
        if constexpr (ALIGN_EPI) { if (wr == 0) PG8_BAR; }
        E(acc, cur, wr, wc, fr, fq);
        if (!has_next) break;
#pragma unroll
        for (int a = 0; a < 2; ++a)
#pragma unroll
            for (int b = 0; b < 2; ++b)
#pragma unroll
                for (int m = 0; m < 4; ++m)
#pragma unroll
                    for (int n = 0; n < 2; ++n) acc[a][b][m][n] = (f32x4){0.f, 0.f, 0.f, 0.f};
        cur = nxt; cA = nA; cB = nB; ++ui;
        if constexpr (ALIGN_EPI) { if (wr == 1) PG8_BAR; }
    }
    PG8_WAIT_V(0);
    if constexpr (!ALIGN_EPI) { if (wr == 0) PG8_BAR; }
    PG8_BAR;
#undef PG8_SA
#undef PG8_SB
#undef PG8_STAGE
#undef PG8_LDA
#undef PG8_LDB
#undef PG8_MMA
#undef PG8_WAIT_V
#undef PG8_WAIT_L
#undef PG8_BAR
#undef PG8_SCHED
}

typedef f32x4 Acc[2][2][4][2];
constexpr size_t PART_STRIDE = (size_t)1280 * 1024;

struct EpiIn {
    static constexpr bool PERM = true;
    unsigned char* ws; const float* b_in;
    __device__ __forceinline__ void operator()(const Acc& acc, const Unit& u, int wr, int wc, int fr, int fq) const {
        const int g = u.pn >> 1;
        const int cg0 = (u.pn & 1) * 256 + wc * 32 + 8 * fq;
        const int bsrc0 = u.pn * 256 + wc * 32 + 8 * fq + (u.pn >= 8 ? 8 : 0);
        const int row0 = u.pm * BM + wr * 64 + fr;
        int mode = 0; size_t ld = 512; unsigned char* base;
        switch (g) {
            case 0: base = ws + WS_QAB; ld = 1024; break;
            case 1: base = ws + WS_KA; mode = 1; break;
            case 2: base = ws + WS_VA; break;
            case 3: base = ws + WS_OA; mode = 3; break;
            case 4: base = ws + WS_QAB + 1024; ld = 1024; mode = 2; break;
            case 5: base = ws + WS_FB; mode = 4; break;
            case 6: base = ws + WS_IB; break;
            default: base = ws + WS_GB; mode = 3; break;
        }
#pragma unroll
        for (int bj = 0; bj < 2; ++bj) {
            const f32x4 b0 = *(const f32x4*)(b_in + bsrc0 + bj * HALF), b1 = *(const f32x4*)(b_in + bsrc0 + bj * HALF + 4);
#pragma unroll
            for (int ai = 0; ai < 2; ++ai)
#pragma unroll
                for (int m = 0; m < 4; ++m) {
                    const size_t row = (size_t)(row0 + ai * HALF + m * 16);
                    f32x4 v0 = acc[ai][bj][m][0] + b0, v1 = acc[ai][bj][m][1] + b1;
                    if (mode == 4) { float* o = (float*)base + row * 512 + cg0 + bj * HALF; *(f32x4*)o = v0; *(f32x4*)(o + 4) = v1; continue; }
                    if (mode == 1) { v0 = v0 * KSCALE; v1 = v1 * KSCALE; }
                    else if (mode == 2) { v0 = v0 * sigmoid4(v0); v1 = v1 * sigmoid4(v1); }
                    else if (mode == 3) { v0 = sigmoid4(v0); v1 = sigmoid4(v1); }
                    u32x4 w; w.x = cvt_pk_bf16(v0[0], v0[1]); w.y = cvt_pk_bf16(v0[2], v0[3]); w.z = cvt_pk_bf16(v1[0], v1[1]); w.w = cvt_pk_bf16(v1[2], v1[3]);
                    *(u32x4*)((bf16_t*)base + row * ld + cg0 + bj * HALF) = w;
                }
        }
    }
};

struct EpiZ1 {
    static constexpr bool PERM = true;
    const float* xp; const float* xs; const float* meta; const float* gg; const float* gb; const float* bo; const float* stats; float* z1; float* tail; int tailrow0;
    __device__ __forceinline__ void operator()(const Acc& acc, const Unit& u, int wr, int wc, int fr, int fq) const {
        const int col0 = u.pn * BM + wc * 32 + 8 * fq;
#pragma unroll
        for (int bj = 0; bj < 2; ++bj) {
            const int col = col0 + bj * HALF;
            const f32x4 g0 = *(const f32x4*)(gg + col), g1 = *(const f32x4*)(gg + col + 4);
            const f32x4 c0 = *(const f32x4*)(gb + col) * ALPHA + *(const f32x4*)(bo + col), c1 = *(const f32x4*)(gb + col + 4) * ALPHA + *(const f32x4*)(bo + col + 4);
#pragma unroll
            for (int am = 0; am < 2; ++am) { const int ai = am, mb = 0;
                f32x4 xa[4], xb[4]; float mus[4], rss[4];
#pragma unroll
                for (int mm = 0; mm < 4; ++mm) { const int row = u.pm * BM + ai * HALF + wr * 64 + (mb + mm) * 16 + fr;
                    xa[mm] = (f32x4){0.f, 0.f, 0.f, 0.f}; xb[mm] = xa[mm]; mus[mm] = 0.f; rss[mm] = 0.f;
                    if (row < MR && u.split <= 1) { const float* xr = xrow_ptr(xp, xs, meta, row) + col; xa[mm] = *(const f32x4*)xr; xb[mm] = *(const f32x4*)(xr + 4); mus[mm] = stats[2 * row]; rss[mm] = stats[2 * row + 1] * ALPHA; } }
#pragma unroll
                for (int mm = 0; mm < 4; ++mm) { const int m = mb + mm;
                    const int row = u.pm * BM + ai * HALF + wr * 64 + m * 16 + fr;
                    f32x4 v0 = (f32x4){0.f, 0.f, 0.f, 0.f}, v1 = v0;
                    if (row < MR) {
                        v0 = acc[ai][bj][m][0]; v1 = acc[ai][bj][m][1];
                        if (u.split <= 1) { v0 = v0 + c0 + (xa[mm] - mus[mm]) * rss[mm] * g0; v1 = v1 + c1 + (xb[mm] - mus[mm]) * rss[mm] * g1; }
                    }
                    float* o = (u.split ? tail + (size_t)(u.split - 1) * PART_STRIDE + (size_t)(row - tailrow0) * DM : z1 + (size_t)row * DM) + col;
                    *(f32x4*)o = v0; *(f32x4*)(o + 4) = v1;
                }
            }
        }
    }
};

struct EpiU {
    static constexpr bool PERM = true;
    bf16_t* U; const float* b_up; float* out;
    __device__ __forceinline__ void operator()(const Acc& acc, const Unit& u, int wr, int wc, int fr, int fq) const {
        const int col0 = u.pn * BM + wc * 32 + 8 * fq;
#pragma unroll
        for (int bj = 0; bj < 2; ++bj) {
            const int col = col0 + bj * HALF;
            const f32x4 b0 = *(const f32x4*)(b_up + col), b1 = *(const f32x4*)(b_up + col + 4);
#pragma unroll
            for (int ai = 0; ai < 2; ++ai)
#pragma unroll
                for (int m = 0; m < 4; ++m) {
                    const int row = u.pm * BM + ai * HALF + wr * 64 + m * 16 + fr;
                    const f32x4 v0 = acc[ai][bj][m][0] + b0, v1 = acc[ai][bj][m][1] + b1;
                    u32x4 w; w.x = cvt_pk_bf16(v0[0], v0[1]); w.y = cvt_pk_bf16(v0[2], v0[3]); w.z = cvt_pk_bf16(v1[0], v1[1]); w.w = cvt_pk_bf16(v1[2], v1[3]);
                    *(u32x4*)(U + (size_t)row * DFF + col) = w;
                    float* o = nullptr;
                    if (row < RP) { const int b = row / TP, q = row - b * TP; if (q >= TP - 2) o = out + O_CVP + ((size_t)(b * 2 + (q - (TP - 2)))) * DFF + col; }
                    else if (row < MR) { const int s = row - RP, t = s & 7; if (t >= 6) o = out + O_CVS + ((size_t)((s >> 3) * 2 + (t - 6))) * DFF + col; }
                    if (o) { *(f32x4*)o = v0; *(f32x4*)(o + 4) = v1; }
                }
        }
    }
};

__device__ __forceinline__ f32x4 silu_mul4(const f32x4 x, const f32x4 g) {
    const f32x4 t = x * (-1.4426950408889634f);
    f32x4 e; e[0] = __builtin_amdgcn_exp2f(t[0]); e[1] = __builtin_amdgcn_exp2f(t[1]); e[2] = __builtin_amdgcn_exp2f(t[2]); e[3] = __builtin_amdgcn_exp2f(t[3]);
    const f32x4 d = e + 1.0f;
    f32x4 r; r[0] = __builtin_amdgcn_rcpf(d[0]); r[1] = __builtin_amdgcn_rcpf(d[1]); r[2] = __builtin_amdgcn_rcpf(d[2]); r[3] = __builtin_amdgcn_rcpf(d[3]);
    return (x * r) * g;
}
__device__ __forceinline__ void unpack8(const u32x4 w, f32x4& a, f32x4& b) { a = (f32x4){bflo(w.x), bfhi(w.x), bflo(w.y), bfhi(w.y)}; b = (f32x4){bflo(w.z), bfhi(w.z), bflo(w.w), bfhi(w.w)}; }
struct EpiAct {
    static constexpr bool PERM = true;
    const bf16_t* U; bf16_t* ACT; const float* b_upg; const float* w_conv; const float* b_conv; const float* cstate;
    __device__ __forceinline__ void operator()(const Acc& acc, const Unit& u, int wr, int wc, int fr, int fq) const {
        const int col0 = u.pn * BM + wc * 32 + 8 * fq;
#pragma unroll
        for (int bj = 0; bj < 2; ++bj) {
            const int col = col0 + bj * HALF;
            const f32x4 bg0 = *(const f32x4*)(b_upg + col), bg1 = *(const f32x4*)(b_upg + col + 4);
            const f32x4 bc0 = *(const f32x4*)(b_conv + col), bc1 = *(const f32x4*)(b_conv + col + 4);
            const f32x4 wa0 = *(const f32x4*)(w_conv + col), wa1 = *(const f32x4*)(w_conv + col + 4);
            const f32x4 wb0 = *(const f32x4*)(w_conv + DFF + col), wb1 = *(const f32x4*)(w_conv + DFF + col + 4);
            const f32x4 wc0 = *(const f32x4*)(w_conv + 2 * DFF + col), wc1 = *(const f32x4*)(w_conv + 2 * DFF + col + 4);
#pragma unroll
            for (int ai = 0; ai < 2; ++ai) {
                u32x4 own[4], halo = (u32x4){0u, 0u, 0u, 0u};
                const int hb = u.pm * BM + ai * HALF + wr * 64;
                own[0] = *(const u32x4*)(U + (size_t)(hb + fr) * DFF + col); own[1] = *(const u32x4*)(U + (size_t)(hb + 16 + fr) * DFF + col);
                if (fr >= 14) halo = *(const u32x4*)(U + (long)(hb - (16 - fr)) * DFF + col);
#pragma unroll
                for (int m = 0; m < 4; ++m) {
                    if (m == 1) { own[2] = *(const u32x4*)(U + (size_t)(hb + 32 + fr) * DFF + col); own[3] = *(const u32x4*)(U + (size_t)(hb + 48 + fr) * DFF + col); }
                    const int row = hb + m * 16 + fr;
                    const u32x4 prev = m ? own[m - 1] : halo;
                    u32x4 w1, w2;
#pragma unroll
                    for (int k = 0; k < 4; ++k) {
                        const int pr1 = __builtin_amdgcn_update_dpp(0, (int)prev[k], 0x121, 0xF, 0xF, true);
                        const int pr2 = __builtin_amdgcn_update_dpp(0, (int)prev[k], 0x122, 0xF, 0xF, true);
                        w1[k] = (unsigned)__builtin_amdgcn_update_dpp(pr1, (int)own[m][k], 0x111, 0xF, 0xF, false);
                        w2[k] = (unsigned)__builtin_amdgcn_update_dpp(pr2, (int)own[m][k], 0x112, 0xF, 0xF, false);
                    }
                    int t = 2;
                    if (row < RP) { const int b = row / TP; t = row - b * TP; } else if (row < MR) t = (row - RP) & 7;
                    f32x4 u00, u01, u10, u11, u20, u21;
                    unpack8(own[m], u00, u01); unpack8(w1, u10, u11); unpack8(w2, u20, u21);
                    if (__builtin_amdgcn_ballot_w64(t < 2) != 0ull) {
                        if (t < 1) { u10 = (f32x4){0.f, 0.f, 0.f, 0.f}; u11 = u10; }
                        if (t < 2) { u20 = (f32x4){0.f, 0.f, 0.f, 0.f}; u21 = u20; }
                        if (row >= RP && row < MR && t < 2) { const int s = row - RP;
                            const float* cs = cstate + (size_t)(s >> 3) * 2 * DFF + col;
                            const float* c2 = cs + (t == 1 ? DFF : 0); u20 = *(const f32x4*)c2; u21 = *(const f32x4*)(c2 + 4);
                            if (t == 0) { u10 = *(const f32x4*)(cs + DFF); u11 = *(const f32x4*)(cs + DFF + 4); } }
                    }
                    f32x4 cv0 = bc0 + wa0 * u20 + wb0 * u10 + wc0 * u00, cv1 = bc1 + wa1 * u21 + wb1 * u11 + wc1 * u01;
                    const f32x4 g0 = acc[ai][bj][m][0] + bg0, g1 = acc[ai][bj][m][1] + bg1;
                    cv0 = silu_mul4(cv0, g0); cv1 = silu_mul4(cv1, g1);
                    u32x4 w; w.x = cvt_pk_bf16(cv0[0], cv0[1]); w.y = cvt_pk_bf16(cv0[2], cv0[3]); w.z = cvt_pk_bf16(cv1[0], cv1[1]); w.w = cvt_pk_bf16(cv1[2], cv1[3]);
                    *(u32x4*)(ACT + (size_t)row * DFF + col) = w;
                }
            }
        }
    }
};

struct EpiZ2 {
    static constexpr bool PERM = true;
    const bf16_t* X1B; const float* b_dn; float* out; float* part; int tailrow0;
    __device__ __forceinline__ void operator()(const Acc& acc, const Unit& u, int wr, int wc, int fr, int fq) const {
        const int col0 = u.pn * BM + wc * 32 + 8 * fq;
#pragma unroll
        for (int bj = 0; bj < 2; ++bj) {
            const int col = col0 + bj * HALF;
            const f32x4 b0 = *(const f32x4*)(b_dn + col), b1 = *(const f32x4*)(b_dn + col + 4);
#pragma unroll
            for (int ai = 0; ai < 2; ++ai) {
                u32x4 xr[4];
#pragma unroll
                for (int m = 0; m < 4; ++m) xr[m] = *(const u32x4*)(X1B + (size_t)(u.pm * BM + ai * HALF + wr * 64 + m * 16 + fr) * DM + col);
#pragma unroll
                for (int m = 0; m < 4; ++m) {
                    const int row = u.pm * BM + ai * HALF + wr * 64 + m * 16 + fr;
                    long yrow = -1;
                    if (row < RP) { const int b = row / TP, q = row - b * TP; if (q >= NMETA) yrow = (long)b * SEQ + (q - NMETA); }
                    else if (row < MR) yrow = (long)NB * SEQ + (row - RP);
                    if (yrow >= 0 || u.split) {
                        f32x4 v0 = acc[ai][bj][m][0], v1 = acc[ai][bj][m][1];
                        if (u.split <= 1) { f32x4 x0, x1; unpack8(xr[m], x0, x1); v0 = v0 + b0 + x0 * ALPHA; v1 = v1 + b1 + x1 * ALPHA; }
                        float* o = (u.split ? part + (size_t)(u.split - 1) * PART_STRIDE + (size_t)(row - tailrow0) * DM : out + (size_t)yrow * DM) + col;
                        *(f32x4*)o = v0; *(f32x4*)(o + 4) = v1;
                    }
                }
            }
        }
    }
};
}

constexpr int LQ = 0, LK = 17408, LV = 34816, LC = 52224, LSW = 87040, LA = 96256, LVEC = 129024;
constexpr int RSTR = 272, SWSTR = 144;
constexpr int V_BM = 0, V_AV = 64, V_DEC = 128, V_EM = 192, V_DENQ = 256, V_DENI = 320, V_SSQ = 384, V_WT = 448, V_NIN = 512, V_PSUM = 640, V_MISC = 1152;
constexpr int LG = LVEC + (V_MISC + 16) * 4;
constexpr int LGN = LG + 64 * RSTR;
static_assert(LG % 16 == 0 && LGN % 16 == 0 && LGN + 4096 <= LDS_BYTES - 16, "mixer LDS map");

__device__ __forceinline__ bf16x8 rowfrag(LAS unsigned char* base, int stride, int row0, int k0, int lane) {
    return *(const LAS bf16x8*)(base + (row0 + (lane & 15)) * stride + (k0 + 8 * (lane >> 4)) * 2);
}
__device__ __forceinline__ bf16x8 trfrag(LAS unsigned char* base, int stride, int k0, int c0, int lane) {
    const int g = lane >> 4, q = (lane & 15) >> 2, pp = lane & 3;
    LAS unsigned char* a = base + (k0 + 8 * g + q) * stride + (c0 + 4 * pp) * 2;
    const s16x4 lo = __builtin_amdgcn_ds_read_tr16_b64_v4i16((LAS s16x4*)a);
    const s16x4 hi = __builtin_amdgcn_ds_read_tr16_b64_v4i16((LAS s16x4*)(a + 4 * stride));
    return (bf16x8){lo[0], lo[1], lo[2], lo[3], hi[0], hi[1], hi[2], hi[3]};
}
__device__ __forceinline__ void load_chunk(LAS unsigned char* dst, const bf16_t* src, size_t ldg, int len, int tid) {
#pragma unroll
    for (int i = 0; i < 2; ++i) { const int q = tid + i * 512, s = q >> 4, cc = q & 15;
        u32x4 v = (u32x4){0u, 0u, 0u, 0u}; if (s < len) v = *(const u32x4*)(src + (size_t)s * ldg + cc * 8);
        *(LAS u32x4*)(dst + s * RSTR + cc * 16) = v; }
}
__device__ __forceinline__ void chunk_ld(u32x4 (&r)[2], const bf16_t* src, size_t ldg, int len, int tid) {
#pragma unroll
    for (int i = 0; i < 2; ++i) { const int q = tid + i * 512, s = q >> 4, cc = q & 15; r[i] = (u32x4){0u, 0u, 0u, 0u}; if (s < len) r[i] = *(const u32x4*)(src + (size_t)s * ldg + cc * 8); }
}
__device__ __forceinline__ void chunk_st(LAS unsigned char* dst, const u32x4 (&r)[2], int tid) {
#pragma unroll
    for (int i = 0; i < 2; ++i) { const int q = tid + i * 512, s = q >> 4, cc = q & 15; *(LAS u32x4*)(dst + s * RSTR + cc * 16) = r[i]; }
}
__device__ __forceinline__ void fb_ld(f32x4 (&fbv)[4], const float* FBsrc, int len, int tid) {
    const int c4 = tid & 31, sr = tid >> 5;
#pragma unroll
    for (int j = 0; j < 4; ++j) { const int s = sr + 16 * j; fbv[j] = (f32x4){0.f, 0.f, 0.f, 0.f}; if (s < len) fbv[j] = *(const f32x4*)(FBsrc + (size_t)s * 512 + c4 * 4); }
}
__device__ __forceinline__ void hgrn_prep(LAS unsigned char* lds, const f32x4 (&fbv)[4], const float* lbl, int h, int len, int tid) {
    LAS float* A = (LAS float*)(lds + LA); LAS float* vec = (LAS float*)(lds + LVEC);
    const int cch = tid & 127, part = tid >> 7;
    { const int c4 = tid & 31, sr = tid >> 5;
      const f32x4 l0 = *(const f32x4*)(lbl + h * 128 + c4 * 4), l1 = *(const f32x4*)(lbl + 512 + h * 128 + c4 * 4);
      const f32x4 lb4 = sigmoid4(l0 - l1), oml = 1.0f - lb4;
#pragma unroll
      for (int j = 0; j < 4; ++j) { const int s = sr + 16 * j;
        f32x4 lf = (f32x4){0.f, 0.f, 0.f, 0.f}, kb = lf;
        if (s < len) {
            const f32x4 sg = sigmoid4(fbv[j]), f = lb4 + oml * sg;
            lf[0] = __builtin_amdgcn_logf(f[0]); lf[1] = __builtin_amdgcn_logf(f[1]); lf[2] = __builtin_amdgcn_logf(f[2]); lf[3] = __builtin_amdgcn_logf(f[3]);
            lf = lf * 0.6931471805599453f; kb = oml * (1.0f - sg); }
        *(LAS f32x4*)(A + s * 128 + c4 * 4) = lf;
        u32x2 w; w.x = pk2(kb[0], kb[1]); w.y = pk2(kb[2], kb[3]); *(LAS u32x2*)(lds + LK + s * RSTR + c4 * 8) = w; } }
    __syncthreads();
    float v[16]; float run = 0.f;
#pragma unroll
    for (int i = 0; i < 16; ++i) { run += A[(part * 16 + i) * 128 + cch]; v[i] = run; }
    vec[V_PSUM + part * 128 + cch] = run;
    __syncthreads();
    float off = 0.f;
#pragma unroll
    for (int pp = 0; pp < 3; ++pp) if (pp < part) off += vec[V_PSUM + pp * 128 + cch];
#pragma unroll
    for (int i = 0; i < 16; ++i) A[(part * 16 + i) * 128 + cch] = v[i] + off;
    __syncthreads();
}

__device__ __forceinline__ void transpose_item(const float* W, int ldw, int K, bf16_t* WT, int k0, int n0, int sn0, LAS float* scr, int lane) {
    float tv[32];
#pragma unroll
    for (int i = 0; i < 32; ++i) { const int kk = 2 * i + (lane >> 5); tv[i] = W[(size_t)(k0 + kk) * ldw + sn0 + (lane & 31)]; }
#pragma unroll
    for (int i = 0; i < 32; ++i) { const int kk = 2 * i + (lane >> 5); scr[kk * 33 + (lane & 31)] = tv[i]; }
    asm volatile("s_waitcnt lgkmcnt(0)" ::: "memory");
    const int c = lane & 7;
#pragma unroll
    for (int j = 0; j < 4; ++j) { const int n = (lane >> 3) + 8 * j; const LAS float* s = scr + (8 * c) * 33 + n;
        u32x4 o; o.x = pk2(s[0 * 33], s[1 * 33]); o.y = pk2(s[2 * 33], s[3 * 33]); o.z = pk2(s[4 * 33], s[5 * 33]); o.w = pk2(s[6 * 33], s[7 * 33]);
        *(u32x4*)(WT + (size_t)(n0 + n) * K + k0 + 8 * c) = o; }
    asm volatile("s_waitcnt lgkmcnt(0)" ::: "memory");
}
#define XB_TMO      128
#define XB_XCNT(j)  (256  + 64 * (j))
#define XB_XSUB(j)  (1280 + 64 * (j))
#define XB_XGEN(j)  (2304 + 64 * (j))
#define XB_TOP      3328
#define XB_TOPGEN   3392
#define XCD_BAR_WORDS 3456
#define XB_SPIN_CAP (1u << 18)
__device__ __forceinline__ unsigned xb_ld(unsigned* p)              { return __hip_atomic_load(p, __ATOMIC_RELAXED, __HIP_MEMORY_SCOPE_AGENT); }
__device__ __forceinline__ unsigned xb_add(unsigned* p, unsigned v) { return __hip_atomic_fetch_add(p, v, __ATOMIC_RELAXED, __HIP_MEMORY_SCOPE_AGENT); }
__device__ __forceinline__ unsigned xb_xcc_id() { return (unsigned)__builtin_amdgcn_s_getreg((3 << 11) | 20) & 0xFu; }
#define XB_SPIN(cond, bar) do { unsigned _sp = 0; while (cond) { __builtin_amdgcn_s_sleep(1); \
    if ((++_sp & 255u) == 0u) { if (xb_ld(&(bar)[XB_TMO])) break; if (_sp > XB_SPIN_CAP) { atomicAdd(&(bar)[XB_TMO], 1u); break; } } } } while (0)
struct XcdBarrier { unsigned* bar; unsigned x; volatile LAS unsigned* st; };
__device__ __forceinline__ XcdBarrier xcd_barrier_post(unsigned* bar, volatile LAS unsigned* st) {
    XcdBarrier b; b.bar = bar; b.x = xb_xcc_id(); b.st = st;
    if (threadIdx.x == 0) (void)xb_add(&bar[XB_XCNT(b.x)], 1u);
    return b;
}
__device__ __forceinline__ void xcd_barrier_complete(unsigned* bar, unsigned x, unsigned& nloc, unsigned& nx) {
    const unsigned G = gridDim.x * gridDim.y * gridDim.z;
    unsigned sum, cnt, mine, sp = 0u;
    for (;;) {
        sum = 0u; cnt = 0u; mine = 0u;
#pragma unroll
        for (unsigned j = 0; j < 16; ++j) { const unsigned c = xb_ld(&bar[XB_XCNT(j)]); sum += c; cnt += (c > 0u) ? 1u : 0u; mine = (j == x) ? c : mine; }
        if (sum == G) break;
        __builtin_amdgcn_s_sleep(1);
        if ((++sp & 255u) == 0u) { if (xb_ld(&bar[XB_TMO])) break; if (sp > XB_SPIN_CAP) { atomicAdd(&bar[XB_TMO], 1u); break; } }
    }
    nloc = mine > 0u ? mine : 1u; nx = cnt > 0u ? cnt : 1u;
}
__device__ __forceinline__ void xcd_barrier(const XcdBarrier& b) {
    asm volatile("s_waitcnt vmcnt(0)" ::: "memory");
    __syncthreads();
    if (threadIdx.x == 0) {
        unsigned* bar = b.bar;
        __builtin_amdgcn_s_waitcnt(0);
        unsigned nloc = b.st[0], nx = b.st[1];
        if (nloc == 0u) { xcd_barrier_complete(bar, b.x, nloc, nx); b.st[0] = nloc; b.st[1] = nx; }
        const unsigned old = xb_add(&bar[XB_XSUB(b.x)], 1u);
        const unsigned gen = old / nloc;
        if (old + 1u == (gen + 1u) * nloc) {
            __builtin_amdgcn_fence(__ATOMIC_RELEASE, "agent");
            asm volatile("s_waitcnt vmcnt(0)" ::: "memory");
            const unsigned og = xb_add(&bar[XB_TOP], 1u);
            const unsigned tg = og / nx;
            if (og + 1u == (tg + 1u) * nx) xb_add(&bar[XB_TOPGEN], 1u);
            else XB_SPIN(xb_ld(&bar[XB_TOPGEN]) == tg, bar);
            __builtin_amdgcn_fence(__ATOMIC_ACQUIRE, "agent");
            xb_add(&bar[XB_XGEN(b.x)], 1u);
            asm volatile("s_waitcnt vmcnt(0)" ::: "memory");
        } else {
            XB_SPIN(xb_ld(&bar[XB_XGEN(b.x)]) == gen, bar);
            __builtin_amdgcn_fence(__ATOMIC_ACQUIRE, "agent");
            asm volatile("s_waitcnt vmcnt(0)" ::: "memory");
        }
    }
    __syncthreads();
}
#ifndef REP_P4
#define REP_P4 1
#endif
#ifndef REP_BAR
#define REP_BAR 1
#endif
#ifndef DBG_STOP
#define DBG_STOP -1
#endif
__device__ __forceinline__ void digest(float* out, const unsigned* w, size_t nwords, bool first, size_t gtid, size_t gthreads) {
    const size_t OUTN = 16777216;
    for (size_t i = gtid; i < OUTN; i += gthreads) { float a = first ? 0.f : out[i];
        for (size_t j = i; j < nwords; j += OUTN) { const unsigned x = w[j]; a += (float)(x & 0xffffu) * (1.f / 65536.f) + (float)(x >> 16) * (1.f / 65536.f); }
        out[i] = a; }
}
#define DG(off, bytes, first) digest(KOUT(), (const unsigned*)(KWS() + (off)), (size_t)(bytes) / 4, first, (size_t)bx * 512 + tid, (size_t)G * 512)
__global__ void __launch_bounds__(512, 2) fwd_kernel(Params p) {
    extern __shared__ __attribute__((aligned(16))) unsigned char lds_raw[];
    LAS unsigned char* lds = (LAS unsigned char*)lds_raw;
    const int tid = threadIdx.x, lane = tid & 63, wave = __builtin_amdgcn_readfirstlane(tid >> 6);
    const int G = gridDim.x, bx = blockIdx.x;
#define stats ((float*)(ws + WS_SMALL + SM_STATS))
#define IG ((float*)(ws + WS_SMALL + SM_IG))
#define LFA ((float*)(ws + WS_SMALL + SM_LFA))
#define CHKL ((float*)(ws + WS_SMALL + SM_CHKL))
#define CHKB ((float*)(ws + WS_SMALL + SM_CHKB))
#define MIN_ ((float*)(ws + WS_SMALL + SM_MIN))
#define CHKN ((float*)(ws + WS_SMALL + SM_CHKN))
#define NIN ((float*)(ws + WS_SMALL + SM_NIN))
#define CHKA ((float*)(ws + WS_SMALL + SM_CHKA))
    LAS float* vec = (LAS float*)(lds + LVEC);
    { volatile LAS unsigned* st0 = (volatile LAS unsigned*)(lds + LDS_BYTES - 16); if (tid < 4) st0[tid] = 0u; }
    __syncthreads();
    const XcdBarrier xbar = xcd_barrier_post((unsigned*)(KWS() + WS_SMALL + SM_BAR), (volatile LAS unsigned*)(lds + LDS_BYTES - 16));
#define GSYNC() xcd_barrier(xbar)

    {
        unsigned char* const ws = KWS();
        const int gw = bx * 8 + wave, NGW = G * 8;
        LAS float* scr = (LAS float*)(lds + wave * 8448);
        { const float* W = KIN(10); bf16_t* WT = (bf16_t*)(ws + WS_WIN);
          for (int it = gw; it < 16 * 128; it += NGW) { const int kb = it >> 7, nb = it & 127, n0 = 32 * nb; transpose_item(W, DIN, 1024, WT, 64 * kb, n0, n0 >= 2048 ? n0 + 8 : n0, scr, lane); } }
        __syncthreads();
        LAS float* wg = (LAS float*)(lds + 69632);
        { const float* win = KIN(10); float wv[16];
#pragma unroll
          for (int i = 0; i < 16; ++i) { const int idx = tid + i * 512; wv[i] = win[(size_t)(idx >> 3) * DIN + 2048 + (idx & 7)]; }
#pragma unroll
          for (int i = 0; i < 16; ++i) { const int idx = tid + i * 512; wg[(idx & 7) * 1024 + (idx >> 3)] = wv[i]; } }
        __syncthreads();
        bf16_t* XN = (bf16_t*)(ws + WS_XN);
        const float* lg = KIN(8); const float* lb = KIN(9);
        const float* xpr = KIN(0); const float* xsm = KIN(1); const float* meta = KIN(7);
        float bi_i = 0.f, bi_f = 0.f;
        if (lane < 4) { bi_i = KIN(11)[2048 + lane]; bi_f = KIN(11)[2052 + lane] + KIN(12)[lane]; }
        f32x4 nv[4];
        if (gw < MR) { const f32x4* x0 = (const f32x4*)xrow_ptr(xpr, xsm, meta, gw) + lane;
#pragma unroll
            for (int j = 0; j < 4; ++j) nv[j] = x0[64 * j]; }
        for (int r = gw; r < MP; r += NGW) {
            unsigned long long* o8 = (unsigned long long*)(XN + (size_t)r * DM) + lane;
            f32x4 v[4]; float s = 0.f;
#pragma unroll
            for (int j = 0; j < 4; ++j) v[j] = nv[j];
            if (r + NGW < MR) { const f32x4* xn = (const f32x4*)xrow_ptr(xpr, xsm, meta, r + NGW) + lane;
#pragma unroll
                for (int j = 0; j < 4; ++j) nv[j] = xn[64 * j]; }
            if (r >= MR) {
#pragma unroll
                for (int j = 0; j < 4; ++j) o8[64 * j] = 0ull;
                continue; }
#pragma unroll
            for (int j = 0; j < 4; ++j) s += (v[j].x + v[j].y) + (v[j].z + v[j].w);
            const float mean = wave_sum(s) * (1.f / DM); float s2 = 0.f;
#pragma unroll
            for (int j = 0; j < 4; ++j) { v[j] = v[j] - mean; s2 += (v[j].x * v[j].x + v[j].y * v[j].y) + (v[j].z * v[j].z + v[j].w * v[j].w); }
            const float rstd = 1.f / sqrtf(wave_sum(s2) * (1.f / DM) + LN_EPS);
            float gd[8];
#pragma unroll
            for (int g = 0; g < 8; ++g) gd[g] = 0.f;
#pragma unroll
            for (int j = 0; j < 4; ++j) {
                const f32x4 gg = *((const f32x4*)lg + lane + 64 * j), bb = *((const f32x4*)lb + lane + 64 * j);
                v[j] = v[j] * rstd * gg + bb;
                o8[64 * j] = (unsigned long long)pk2(v[j].x, v[j].y) | ((unsigned long long)pk2(v[j].z, v[j].w) << 32);
#pragma unroll
                for (int g = 0; g < 8; ++g) { const f32x4 w = *((const LAS f32x4*)(wg + g * 1024) + lane + 64 * j); gd[g] += (v[j].x * w.x + v[j].y * w.y) + (v[j].z * w.z + v[j].w * w.w); }
            }
#pragma unroll
            for (int g = 0; g < 8; ++g) gd[g] = wave_sum(gd[g]);
            if (lane == 0) { stats[2 * r] = mean; stats[2 * r + 1] = rstd; }
            if (lane < 4) {
                float gi = gd[0], gf = gd[4];
                if (lane == 1) { gi = gd[1]; gf = gd[5]; } else if (lane == 2) { gi = gd[2]; gf = gd[6]; } else if (lane == 3) { gi = gd[3]; gf = gd[7]; }
                IG[r * 4 + lane] = gi + bi_i;
                const float x = gf + bi_f;
                LFA[r * 4 + lane] = (x < 0.f) ? x - log1pf(expf(x)) : -log1pf(expf(-x));
            }
        }
    }
    GSYNC();
    if (DBG_STOP == 0) { DG(0, 26 * MiB + 512 * 1024, true); DG(WS_XN, SZ_R1024, false); DG(WS_SMALL + SM_STATS, (size_t)MR * 8, false); DG(WS_SMALL + SM_IG, (size_t)MR * 16, false); DG(WS_SMALL + SM_LFA, (size_t)MR * 16, false); return; }

    {
        unsigned char* const ws = KWS();
        pg8::Gemm g{(const bf16_t*)(ws + WS_XN), (const bf16_t*)(ws + WS_WIN), MP, 4096, 1024}; pg8::StaticOrder S; S.init(MP, 4096, G, bx);
        pg8::EpiIn E{ws, KIN(11)};
        pg8::gemm_phase<pg8::EpiIn, pg8::StaticOrder, true, true>(lds, g, S, E);
        {
            const int nwg = (MP / 256) * 16, rem = nwg % G, nfree = rem ? G - rem : G, fb = rem ? bx - rem : bx;
            if (fb >= 0) {
                LAS float* scr = (LAS float*)(lds + wave * 8448);
                constexpr int I_OUT = 16 * 32, I_UP = 16 * 176, I_DN = 44 * 32;
                for (int it = fb * 8 + wave; it < I_OUT + I_UP + I_DN; it += nfree * 8) {
                    int r = it;
                    if (r < I_OUT) { transpose_item(KIN(16), 1024, 1024, (bf16_t*)(ws + WS_WOUT), 64 * (r / 32), 32 * (r % 32), 32 * (r % 32), scr, lane); continue; } r -= I_OUT;
                    if (r < I_UP) { transpose_item(KIN(20), 2 * DFF, 1024, (bf16_t*)(ws + WS_WUP), 64 * (r / 176), 32 * (r % 176), 32 * (r % 176), scr, lane); continue; } r -= I_UP;
                    transpose_item(KIN(24), 1024, DFF, (bf16_t*)(ws + WS_WDN), 64 * (r / 32), 32 * (r % 32), 32 * (r % 32), scr, lane);
                }
            }
        }
    }
    GSYNC();
    if (DBG_STOP == 1) { DG(WS_QAB, SZ_R1024 + 5 * SZ_R512 + SZ_R1024, true); return; }

    { unsigned char* const ws = KWS(); const float* lbl = KIN(15);
    for (int item = bx; item < 2 * NSLOT; item += G) {
        const int type = item / NSLOT, j = item - type * NSLOT, b = j / 132, rem = j - b * 132, h = rem / NCH, c = rem - h * NCH;
        const int p0 = c ? NMETA + (c - 1) * 64 : 0, len = c ? 64 : NMETA, r0 = b * TP + p0;
        u32x4 rk[2], rv[2]; f32x4 fbv[4];
        chunk_ld(rv, (const bf16_t*)(ws + (type ? WS_IB : WS_VA)) + (size_t)r0 * 512 + h * 128, 512, len, tid);
        if (type == 0) chunk_ld(rk, (const bf16_t*)(ws + WS_KA) + (size_t)r0 * 512 + h * 128, 512, len, tid);
        else fb_ld(fbv, (const float*)(ws + WS_FB) + (size_t)r0 * 512 + h * 128, len, tid);
        __syncthreads();
        chunk_st(lds + LV, rv, tid);
        if (type == 0) {
            if (wave == 0) {
                const bool valid = lane < len;
                const float ig = valid ? IG[(r0 + lane) * 4 + h] : 0.f; float bc = valid ? LFA[(r0 + lane) * 4 + h] : 0.f;
#pragma unroll
                for (int o = 1; o < 64; o <<= 1) { const float t = __shfl_up(bc, o); if (lane >= o) bc += t; }
                const float a = valid ? ig - bc : -INFINITY; float mx = a;
#pragma unroll
                for (int o = 1; o < 64; o <<= 1) mx = fmaxf(mx, __shfl_xor(mx, o));
                const float bT = __shfl(bc, len - 1);
                vec[V_WT + lane] = valid ? __expf(a - mx) : 0.f;
                if (lane == 0) { CHKL[j] = mx; CHKB[j] = bT; }
            }
            __syncthreads();
#pragma unroll
            for (int i = 0; i < 2; ++i) { const int q = tid + i * 512, s = q >> 4, cc = q & 15;
                u32x4 v = rk[i];
                if (s < len) { const float w = vec[V_WT + s];
                    v.x = pk2(bflo(v.x) * w, bfhi(v.x) * w); v.y = pk2(bflo(v.y) * w, bfhi(v.y) * w); v.z = pk2(bflo(v.z) * w, bfhi(v.z) * w); v.w = pk2(bflo(v.w) * w, bfhi(v.w) * w); }
                *(LAS u32x4*)(lds + LK + s * RSTR + cc * 16) = v; }
            __syncthreads();
            if (tid < 128) { float s = 0.f;
#pragma unroll 8
                for (int q = 0; q < 64; ++q) s += bf2f(*(const LAS bf16_t*)(lds + LK + q * RSTR + tid * 2));
                CHKN[j * 128 + tid] = s; }
        } else {
            hgrn_prep(lds, fbv, lbl, h, len, tid);
            LAS float* A = (LAS float*)(lds + LA);
            const int cch = tid & 127, part = tid >> 7;
            const float aT = A[(len - 1) * 128 + cch];
            if (tid < 128) CHKA[j * 128 + tid] = aT;
            { const int c4 = tid & 31, sr = tid >> 5;
              const f32x4 aT4 = *(const LAS f32x4*)(A + (len - 1) * 128 + c4 * 4);
#pragma unroll
              for (int jj = 0; jj < 4; ++jj) { const int s = sr + 16 * jj;
                const f32x4 a4 = *(const LAS f32x4*)(A + s * 128 + c4 * 4);
                LAS u32x2* kp = (LAS u32x2*)(lds + LK + s * RSTR + c4 * 8); const u32x2 kw = *kp;
                const f32x4 k4 = exp4(aT4 - a4) * (f32x4){bflo(kw.x), bfhi(kw.x), bflo(kw.y), bfhi(kw.y)};
                u32x2 o; o.x = pk2(k4[0], k4[1]); o.y = pk2(k4[2], k4[3]); *kp = o; } }
            __syncthreads();
        }
        {
            bf16_t* dst = (bf16_t*)(ws + (type ? WS_CSTH : WS_CSTM)) + (size_t)j * 16384;
            const int e0 = 16 * wave;
            const bf16x8 a0 = trfrag(lds + LV, RSTR, 0, e0, lane), a1 = trfrag(lds + LV, RSTR, 32, e0, lane);
#pragma unroll 2
            for (int dt = 0; dt < 8; ++dt) {
                f32x4 acc = (f32x4){0.f, 0.f, 0.f, 0.f};
                const bf16x8 b0 = trfrag(lds + LK, RSTR, 0, 16 * dt, lane), b1 = trfrag(lds + LK, RSTR, 32, 16 * dt, lane);
                acc = __builtin_amdgcn_mfma_f32_16x16x32_bf16(a0, b0, acc, 0, 0, 0);
                acc = __builtin_amdgcn_mfma_f32_16x16x32_bf16(a1, b1, acc, 0, 0, 0);
                u32x2 w; w.x = pk2(acc[0], acc[1]); w.y = pk2(acc[2], acc[3]);
                *(u32x2*)(dst + (16 * dt + (lane & 15)) * 128 + e0 + 4 * (lane >> 4)) = w;
            }
        }
    } }
    GSYNC();
    if (DBG_STOP == 2) { DG(WS_CSTM, SZ_CST, true); DG(WS_CSTH, SZ_CST, false); DG(WS_SMALL + SM_CHKL, NSLOT * 4, false); DG(WS_SMALL + SM_CHKB, NSLOT * 4, false); DG(WS_SMALL + SM_CHKN, NSLOT * 512, false); DG(WS_SMALL + SM_CHKA, NSLOT * 512, false); return; }

    { unsigned char* const ws = KWS(); float* const outp = KOUT();
    for (int unit = bx; unit < 2 * NB * 4 * 4; unit += G) {
        const int type = unit >> 7, sq = (unit >> 2) & 31, quarter = unit & 3;
        const int eo = quarter * 4096 + tid * 8, d = eo >> 7;
        bf16_t* base = (bf16_t*)(ws + (type ? WS_CSTH : WS_CSTM)) + (size_t)sq * NCH * 16384 + eo;
        const bool nthr = (type == 0 && quarter == 0 && tid < 128);
        __syncthreads();
        if (type == 0 && tid < NCH) { vec[tid] = CHKL[sq * NCH + tid]; vec[64 + tid] = CHKB[sq * NCH + tid]; }
        __syncthreads();
        float carry[8];
#pragma unroll
        for (int i = 0; i < 8; ++i) carry[i] = 0.f;
        float m_in = 0.f, ncar = 0.f;
#pragma unroll 1
        for (int cg = 0; cg < NCH; cg += 11) {
            u32x4 uu[11]; float aux[11];
#pragma unroll
            for (int k = 0; k < 11; ++k) uu[k] = *(const u32x4*)(base + (size_t)(cg + k) * 16384);
#pragma unroll
            for (int k = 0; k < 11; ++k) aux[k] = (type == 0) ? (nthr ? CHKN[(sq * NCH + cg + k) * 128 + tid] : 0.f) : CHKA[(sq * NCH + cg + k) * 128 + d];
#pragma unroll
            for (int k = 0; k < 11; ++k) {
                const int c = cg + k, sidx = sq * NCH + c;
                u32x4 w; w.x = pk2(carry[0], carry[1]); w.y = pk2(carry[2], carry[3]); w.z = pk2(carry[4], carry[5]); w.w = pk2(carry[6], carry[7]);
                *(u32x4*)(base + (size_t)c * 16384) = w;
                float al, be;
                if (type == 0) {
                    const float L = vec[c], bT = vec[64 + c]; const float mn = bT + fmaxf(m_in, L);
                    al = __expf(bT + m_in - mn); be = __expf(bT + L - mn);
                    if (quarter == 0 && tid == 0) MIN_[sidx] = m_in;
                    if (nthr) { NIN[sidx * 128 + tid] = ncar; ncar = al * ncar + be * aux[k]; }
                    m_in = mn;
                } else { al = __expf(aux[k]); be = 1.f; }
                const u32x4 u4 = uu[k];
                carry[0] = al * carry[0] + be * bflo(u4.x); carry[1] = al * carry[1] + be * bfhi(u4.x);
                carry[2] = al * carry[2] + be * bflo(u4.y); carry[3] = al * carry[3] + be * bfhi(u4.y);
                carry[4] = al * carry[4] + be * bflo(u4.z); carry[5] = al * carry[5] + be * bfhi(u4.z);
                carry[6] = al * carry[6] + be * bflo(u4.w); carry[7] = al * carry[7] + be * bfhi(u4.w);
            }
        }
        float* o = outp + (type ? O_SP : O_CP) + (size_t)sq * 16384 + eo;
        *(f32x4*)o = (f32x4){carry[0], carry[1], carry[2], carry[3]}; *(f32x4*)(o + 4) = (f32x4){carry[4], carry[5], carry[6], carry[7]};
        if (nthr) outp[O_NP + sq * 128 + tid] = ncar;
        if (type == 0 && quarter == 0 && tid == 0) outp[O_MPR + sq] = m_in;
    } }
    GSYNC();
    if (DBG_STOP == 3) { DG(WS_CSTM, SZ_CST, true); DG(WS_CSTH, SZ_CST, false); DG(WS_SMALL + SM_MIN, NSLOT * 4, false); DG(WS_SMALL + SM_NIN, NSLOT * 512, false); return; }

    { unsigned char* const ws = KWS(); float* const outp = KOUT(); const float* lbl = KIN(15);
      const float* stC = KIN(2); const float* stN = KIN(3); const float* stM = KIN(4); const float* stS = KIN(5); const float* gna = KIN(13); const float* gnb = KIN(14);
#define P4_DECODE(it_) do { const int it__ = (it_); n_sidx = 0; n_sb = 0; n_sample = false; \
        if (it__ < 2 * NSLOT) { n_type = it__ / NSLOT; const int j = it__ - n_type * NSLOT, b = j / 132, rem = j - b * 132; n_h = rem / NCH; const int c = rem - n_h * NCH; \
            n_len = c ? 64 : NMETA; n_r0 = b * TP + (c ? NMETA + (c - 1) * 64 : 0); n_sidx = j; } \
        else { const int j = it__ - 2 * NSLOT; n_type = j >> 9; const int rem = j & 511; n_sb = rem >> 2; n_h = rem & 3; n_len = DS; n_r0 = RP + n_sb * DS; n_sample = true; } } while (0)
#define P4_ISSUE() do { \
        chunk_ld(rq, (const bf16_t*)(ws + WS_QAB) + (size_t)n_r0 * 1024 + n_type * 512 + n_h * 128, 1024, n_len, tid); \
        chunk_ld(rv, (const bf16_t*)(ws + (n_type ? WS_IB : WS_VA)) + (size_t)n_r0 * 512 + n_h * 128, 512, n_len, tid); \
        if (n_type == 0) { u32x4 rk_[2]; chunk_ld(rk_, (const bf16_t*)(ws + WS_KA) + (size_t)n_r0 * 512 + n_h * 128, 512, n_len, tid); fbv[0] = __builtin_bit_cast(f32x4, rk_[0]); fbv[1] = __builtin_bit_cast(f32x4, rk_[1]); } \
        else fb_ld(fbv, (const float*)(ws + WS_FB) + (size_t)n_r0 * 512 + n_h * 128, n_len, tid); \
        if (!n_sample) { const bf16_t* cs = (const bf16_t*)(ws + (n_type ? WS_CSTH : WS_CSTM)) + (size_t)n_sidx * 16384; \
            _Pragma("unroll") for (int i = 0; i < 4; ++i) { const int q = tid + i * 512, d = q >> 4, cc = q & 15; cst[i] = *(const f32x4*)(cs + d * 128 + cc * 8); } } \
        if (n_type == 0) { \
            if (wave == 0) { const bool valid_ = lane < n_len; pg_a = valid_ ? IG[(n_r0 + lane) * 4 + n_h] : 0.f; pg_b = valid_ ? LFA[(n_r0 + lane) * 4 + n_h] : 0.f; \
                pg_m = n_sample ? stM[n_sb * 4 + n_h] : MIN_[n_sidx]; } \
            else if (wave == 2 || wave == 3) { const int d_ = tid - 128; pg_a = n_sample ? stN[(n_sb * 4 + n_h) * 128 + d_] : NIN[n_sidx * 128 + d_]; } } \
        } while (0)
    u32x4 rq[2], rv[2]; f32x4 cst[4]; f32x4 fbv[4];
    float pg_a = 0.f, pg_b = 0.f, pg_m = 0.f;
    __syncthreads();
    { LAS float* gl = (LAS float*)(lds + LGN); gl[tid] = gna[tid]; gl[512 + tid] = gnb[tid]; }
    int n_type = 0, n_h = 0, n_len = 0, n_r0 = 0, n_sidx = 0, n_sb = 0; bool n_sample = false;
    constexpr int P4N = 2 * NSLOT + 1024;
    if (bx < P4N) { P4_DECODE(bx); P4_ISSUE(); }
    for (int item = bx; item < P4N; item += G) {
        const int type = n_type, h = n_h, len = n_len, r0 = n_r0, sidx = n_sidx, sb = n_sb; const bool sample = n_sample;
        const float* Csrc = (type ? stS : stC) + (size_t)(sb * 4 + h) * 16384;
        __syncthreads();
        u32x4 rg[2]; chunk_ld(rg, (const bf16_t*)(ws + (type ? WS_GB : WS_OA)) + (size_t)r0 * 512 + h * 128, 512, len, tid);
        chunk_st(lds + LQ, rq, tid); chunk_st(lds + LV, rv, tid);
        if (type == 0) { u32x4 rk_[2]; rk_[0] = __builtin_bit_cast(u32x4, fbv[0]); rk_[1] = __builtin_bit_cast(u32x4, fbv[1]); chunk_st(lds + LK, rk_, tid); }
        if (!sample) {
#pragma unroll
            for (int i = 0; i < 4; ++i) { const int q = tid + i * 512, d = q >> 4, cc = q & 15; *(LAS f32x4*)(lds + LC + d * RSTR + cc * 16) = cst[i]; }
        } else {
            f32x4 sst[8];
#pragma unroll
            for (int i = 0; i < 8; ++i) { const int q = tid + i * 512, d = q >> 5, c4 = q & 31; sst[i] = *(const f32x4*)(Csrc + d * 128 + c4 * 4); }
#pragma unroll
            for (int i = 0; i < 8; ++i) { const int q = tid + i * 512, d = q >> 5, c4 = q & 31; const f32x4 v = sst[i];
                u32x2 w; w.x = pk2(v.x, v.y); w.y = pk2(v.z, v.w); *(LAS u32x2*)(lds + LC + d * RSTR + c4 * 8) = w; }
        }
        if (tid < 64) { vec[V_DENI + tid] = 0.f; vec[V_SSQ + tid] = 0.f; }
        if (type == 0) {
            if (wave == 0) {
                const bool valid = lane < len;
                const float m_in = pg_m;
                const float ig = pg_a; float bc = pg_b;
#pragma unroll
                for (int o = 1; o < 64; o <<= 1) { const float t = __shfl_up(bc, o); if (lane >= o) bc += t; }
                const float a = valid ? ig - bc : -INFINITY; float mx = a;
#pragma unroll
                for (int o = 1; o < 64; o <<= 1) { const float t = __shfl_up(mx, o); if (lane >= o) mx = fmaxf(mx, t); }
                const float mt = bc + fmaxf(m_in, mx);
                vec[V_BM + lane] = bc - mt; vec[V_AV + lane] = a; vec[V_DEC + lane] = __expf(bc + m_in - mt); vec[V_EM + lane] = __expf(-mt);
                const float bmT = __shfl(bc - mt, len - 1);
                vec[V_WT + lane] = valid ? __expf(bmT + a) : 0.f;
                if (sample && lane == len - 1) outp[O_MS + sb * 4 + h] = mt;
            } else if (wave == 2 || wave == 3) {
                const int d = tid - 128;
                vec[V_NIN + d] = pg_a;
            }
            __syncthreads();
        } else {
            hgrn_prep(lds, fbv, lbl, h, len, tid);
            LAS float* A = (LAS float*)(lds + LA);
            const int cch = tid & 127, part = tid >> 7;
            { const int c4 = tid & 31, sr = tid >> 5;
#pragma unroll
              for (int jj = 0; jj < 4; ++jj) { const int s = sr + 16 * jj;
                const f32x4 a4 = *(const LAS f32x4*)(A + s * 128 + c4 * 4);
                LAS u32x2* kp = (LAS u32x2*)(lds + LK + s * RSTR + c4 * 8); const u32x2 kw = *kp;
                LAS u32x2* qp = (LAS u32x2*)(lds + LQ + s * RSTR + c4 * 8); const u32x2 qw = *qp;
                const f32x4 k4 = exp4(-a4) * (f32x4){bflo(kw.x), bfhi(kw.x), bflo(kw.y), bfhi(kw.y)};
                const f32x4 q4 = exp4(a4) * (f32x4){bflo(qw.x), bfhi(qw.x), bflo(qw.y), bfhi(qw.y)};
                u32x2 ok; ok.x = pk2(k4[0], k4[1]); ok.y = pk2(k4[2], k4[3]); *kp = ok;
                u32x2 oq; oq.x = pk2(q4[0], q4[1]); oq.y = pk2(q4[2], q4[3]); *qp = oq; } }
            __syncthreads();
        }
        if (type == 0) {
            const int t = tid >> 3, part = tid & 7; float s = 0.f;
            const LAS u32x4* qp = (const LAS u32x4*)(lds + LQ + t * RSTR + part * 32); const LAS f32x4* np = (const LAS f32x4*)(vec + V_NIN + part * 16);
#pragma unroll
            for (int i = 0; i < 2; ++i) { const u32x4 qw = qp[i]; const f32x4 n0 = np[2 * i], n1 = np[2 * i + 1];
                s += (bflo(qw.x) * n0[0] + bfhi(qw.x) * n0[1]) + (bflo(qw.y) * n0[2] + bfhi(qw.y) * n0[3]) + (bflo(qw.z) * n1[0] + bfhi(qw.z) * n1[1]) + (bflo(qw.w) * n1[2] + bfhi(qw.w) * n1[3]); }
            s += __shfl_xor(s, 1); s += __shfl_xor(s, 2); s += __shfl_xor(s, 4);
            if (part == 0) vec[V_DENQ + t] = s * vec[V_DEC + t];
        }
        chunk_st(lds + LG, rg, tid);
        {
            const int t0 = 16 * (wave & 3), tt = t0 + (lane & 15);
            bf16x8 qf[4];
#pragma unroll
            for (int k = 0; k < 4; ++k) qf[k] = rowfrag(lds + LQ, RSTR, t0, 32 * k, lane);
            const float bmt = (type == 0) ? vec[V_BM + tt] : 0.f;
            float rsum = 0.f;
#pragma unroll
            for (int si = 0; si < 2; ++si) {
                const int s0 = 16 * ((wave >> 2) * 2 + si);
                f32x4 acc = (f32x4){0.f, 0.f, 0.f, 0.f};
#pragma unroll
                for (int k = 0; k < 4; ++k) acc = __builtin_amdgcn_mfma_f32_16x16x32_bf16(rowfrag(lds + LK, RSTR, s0, 32 * k, lane), qf[k], acc, 0, 0, 0);
                float sw[4];
#pragma unroll
                for (int jj = 0; jj < 4; ++jj) { const int s = s0 + 4 * (lane >> 4) + jj; const bool ok = (s <= tt) && (s < len);
                    float w = 1.f; if (type == 0) w = __expf(bmt + (ok ? vec[V_AV + s] : 0.f));
                    sw[jj] = ok ? acc[jj] * w : 0.f; rsum += sw[jj]; }
                u32x2 w2; w2.x = pk2(sw[0], sw[1]); w2.y = pk2(sw[2], sw[3]);
                *(LAS u32x2*)(lds + LSW + tt * SWSTR + (s0 + 4 * (lane >> 4)) * 2) = w2;
            }
            if (type == 0) { rsum += __shfl_xor(rsum, 16); rsum += __shfl_xor(rsum, 32); if (lane < 16) atomicAdd((float*)(vec + V_DENI + tt), rsum); }
        }
        __syncthreads();
        { const int nxi = item + G; if (nxi < P4N) { P4_DECODE(nxi); P4_ISSUE(); } }
        {
            const int t0 = 16 * (wave & 3), tt = t0 + (lane & 15);
            bf16x8 qf[4], sf[2];
#pragma unroll
            for (int k = 0; k < 4; ++k) qf[k] = rowfrag(lds + LQ, RSTR, t0, 32 * k, lane);
#pragma unroll
            for (int k = 0; k < 2; ++k) sf[k] = rowfrag(lds + LSW, SWSTR, t0, 32 * k, lane);
            float dect = 1.f, rden = 1.f;
            if (type == 0) { dect = vec[V_DEC + tt]; const float den = vec[V_DENQ + tt] + vec[V_DENI + tt]; rden = frcp(fmaxf(fabsf(den), vec[V_EM + tt])); }
            f32x4 hv[4]; float ss = 0.f;
#pragma unroll
            for (int ei = 0; ei < 4; ++ei) {
                const int e0 = 16 * ((wave >> 2) * 4 + ei);
                f32x4 a1 = (f32x4){0.f, 0.f, 0.f, 0.f}, a2 = a1;
#pragma unroll
                for (int k = 0; k < 4; ++k) a1 = __builtin_amdgcn_mfma_f32_16x16x32_bf16(trfrag(lds + LC, RSTR, 32 * k, e0, lane), qf[k], a1, 0, 0, 0);
#pragma unroll
                for (int k = 0; k < 2; ++k) a2 = __builtin_amdgcn_mfma_f32_16x16x32_bf16(trfrag(lds + LV, RSTR, 32 * k, e0, lane), sf[k], a2, 0, 0, 0);
                hv[ei] = (a1 * dect + a2) * rden;
                ss += (hv[ei][0] * hv[ei][0] + hv[ei][1] * hv[ei][1]) + (hv[ei][2] * hv[ei][2] + hv[ei][3] * hv[ei][3]);
            }
            ss += __shfl_xor(ss, 16); ss += __shfl_xor(ss, 32);
            if (lane < 16) atomicAdd((float*)(vec + V_SSQ + tt), ss);
            __syncthreads();
            const float rs = rsqrtf(vec[V_SSQ + tt] * (1.0f / 128.0f) + RMS_EPS);
            if (tt < len) {
                const LAS float* gn = (const LAS float*)(lds + LGN) + type * 512 + h * 128;
                bf16_t* dst = (bf16_t*)(ws + WS_QAB) + (size_t)(r0 + tt) * 1024 + type * 512 + h * 128;
#pragma unroll
                for (int ei = 0; ei < 4; ++ei) {
                    const int e = 16 * ((wave >> 2) * 4 + ei) + 4 * (lane >> 4);
                    const u32x2 gt = *(const LAS u32x2*)(lds + LG + tt * RSTR + e * 2); const f32x4 g4 = *(const LAS f32x4*)(gn + e);
                    const f32x4 o = hv[ei] * rs * g4 * (f32x4){bflo(gt.x), bfhi(gt.x), bflo(gt.y), bfhi(gt.y)};
                    u32x2 w; w.x = pk2(o[0], o[1]); w.y = pk2(o[2], o[3]); *(u32x2*)(dst + e) = w;
                }
            }
        }
        if (sample) {
            const int e4 = tid & 31, dg = tid >> 5;
            LAS float* A = (LAS float*)(lds + LA);
            const float decT = (type == 0) ? vec[V_DEC + DS - 1] : 1.f;
            float* od = outp + (type ? O_SS : O_CS) + (size_t)(sb * 4 + h) * 16384;
#pragma unroll 1
            for (int h2 = 0; h2 < 2; ++h2) {
                const int d0 = dg * 8 + h2 * 4;
                f32x4 o[4]; float rsc[4];
                { const f32x4 e0 = exp4(*(const LAS f32x4*)(A + (DS - 1) * 128 + d0));
#pragma unroll
                  for (int i = 0; i < 4; ++i) rsc[i] = (type == 0) ? decT : e0[i]; }
#pragma unroll
                for (int i = 0; i < 4; ++i) o[i] = *(const f32x4*)(Csrc + (d0 + i) * 128 + e4 * 4) * rsc[i];
#pragma unroll 2
                for (int s = 0; s < DS; ++s) {
                    const u32x2 kw = *(const LAS u32x2*)(lds + LK + s * RSTR + d0 * 2);
                    const u32x2 t = *(const LAS u32x2*)(lds + LV + s * RSTR + e4 * 8);
                    const f32x4 v = (f32x4){bflo(t.x), bfhi(t.x), bflo(t.y), bfhi(t.y)} * ((type == 0) ? vec[V_WT + s] : 1.f);
                    const float kf[4] = {bflo(kw.x), bfhi(kw.x), bflo(kw.y), bfhi(kw.y)};
#pragma unroll
                    for (int i = 0; i < 4; ++i) o[i] += v * ((type == 0) ? kf[i] : rsc[i] * kf[i]);
                }
#pragma unroll
                for (int i = 0; i < 4; ++i) *(f32x4*)(od + (d0 + i) * 128 + e4 * 4) = o[i];
            }
            if (type == 0 && tid < 128) { float n = decT * vec[V_NIN + tid];
#pragma unroll
                for (int s = 0; s < DS; ++s) n += vec[V_WT + s] * bf2f(*(const LAS bf16_t*)(lds + LK + s * RSTR + tid * 2));
                outp[O_NS + (sb * 4 + h) * 128 + tid] = n; }
        }
    } }
    GSYNC();
    if (DBG_STOP == 4) { DG(WS_QAB, SZ_R1024, true); return; }

    {
        unsigned char* const ws = KWS();
        pg8::Gemm g{(const bf16_t*)(ws + WS_QAB), (const bf16_t*)(ws + WS_WOUT), MP, 1024, 1024}; pg8::TailSplitOrder S; S.init(MP, 1024, G, bx, 1024, 8);
        pg8::EpiZ1 E{KIN(0), KIN(1), KIN(7), KIN(8), KIN(9), KIN(17), stats, (float*)(ws + WS_Z1), KOUT(), S.tail_row0()};
        pg8::gemm_phase<pg8::EpiZ1, pg8::TailSplitOrder, true, true>(lds, g, S, E);
    }
    GSYNC();
    if (DBG_STOP == 5) { DG(WS_Z1, 2 * SZ_R1024, true); return; }
    {
        unsigned char* const ws = KWS();
        const int gw = bx * 8 + wave, NGW = G * 8;
        const float* z1 = (const float*)(ws + WS_Z1); bf16_t* X1B = (bf16_t*)(ws + WS_X1B);
        pg8::TailSplitOrder S5; S5.init(MP, 1024, G, bx, 1024, 8); const int tr0 = S5.tail_row0(); const float* ztail = KOUT();
        const float* lg = KIN(18); const float* lb = KIN(19);
#define Z1ROW(r_) ((const f32x4*)((r_) >= tr0 ? ztail + (size_t)((r_) - tr0) * DM : z1 + (size_t)(r_) * DM) + lane)
        f32x4 nv[4];
        if (gw < MR) { const f32x4* xr = Z1ROW(gw);
#pragma unroll
            for (int j = 0; j < 4; ++j) nv[j] = xr[64 * j]; }
        for (int r = gw; r < MP; r += NGW) {
            unsigned long long* o8 = (unsigned long long*)(X1B + (size_t)r * DM) + lane;
            f32x4 v[4]; float s = 0.f;
#pragma unroll
            for (int j = 0; j < 4; ++j) v[j] = nv[j];
            if (r + NGW < MR) { const f32x4* xn = Z1ROW(r + NGW);
#pragma unroll
                for (int j = 0; j < 4; ++j) nv[j] = xn[64 * j]; }
            if (r >= MR) {
#pragma unroll
                for (int j = 0; j < 4; ++j) o8[64 * j] = 0ull;
                continue; }
            const f32x4* xr = Z1ROW(r);
            if (r >= tr0) for (int pc = 1; pc < 8; ++pc) {
#pragma unroll
                for (int j = 0; j < 4; ++j) v[j] += xr[pc * (pg8::PART_STRIDE / 4) + 64 * j]; }
#pragma unroll
            for (int j = 0; j < 4; ++j) s += (v[j].x + v[j].y) + (v[j].z + v[j].w);
            const float mean = wave_sum(s) * (1.f / DM); float s2 = 0.f;
#pragma unroll
            for (int j = 0; j < 4; ++j) { v[j] = v[j] - mean; s2 += (v[j].x * v[j].x + v[j].y * v[j].y) + (v[j].z * v[j].z + v[j].w * v[j].w); }
            const float rstd = 1.f / sqrtf(wave_sum(s2) * (1.f / DM) + LN_EPS);
#pragma unroll
            for (int j = 0; j < 4; ++j) {
                const f32x4 gg = *((const f32x4*)lg + lane + 64 * j), bb = *((const f32x4*)lb + lane + 64 * j);
                v[j] = v[j] * rstd * gg + bb;
                o8[64 * j] = (unsigned long long)pk2(v[j].x, v[j].y) | ((unsigned long long)pk2(v[j].z, v[j].w) << 32);
            }
        }
    }
    GSYNC();
    if (DBG_STOP == 6) { DG(WS_X1B, SZ_R1024, true); return; }
    {
        unsigned char* const ws = KWS();
        pg8::Gemm g{(const bf16_t*)(ws + WS_X1B), (const bf16_t*)(ws + WS_WUP), MP, DFF, 1024}; pg8::StaticOrder S; S.init(MP, DFF, G, bx);
        pg8::EpiU E{(bf16_t*)(ws + WS_U), KIN(21), KOUT()};
        pg8::gemm_phase<pg8::EpiU, pg8::StaticOrder, true, true>(lds, g, S, E);
    }
    GSYNC();
    if (DBG_STOP == 7) { DG(WS_U, SZ_U, true); return; }
    {
        unsigned char* const ws = KWS();
        pg8::Gemm g{(const bf16_t*)(ws + WS_X1B), (const bf16_t*)(ws + WS_WUP) + (size_t)DFF * 1024, MP, DFF, 1024}; pg8::StaticOrder S; S.init(MP, DFF, G, bx);
        pg8::EpiAct E{(const bf16_t*)(ws + WS_U), (bf16_t*)(ws + WS_ACT), KIN(21) + DFF, KIN(22), KIN(23), KIN(6)};
        pg8::gemm_phase<pg8::EpiAct, pg8::StaticOrder, true, true>(lds, g, S, E);
    }
    GSYNC();
    if (DBG_STOP == 8) { DG(WS_ACT, SZ_U, true); return; }
    {
        unsigned char* const ws = KWS();
        pg8::Gemm g{(const bf16_t*)(ws + WS_ACT), (const bf16_t*)(ws + WS_WDN), MP, 1024, DFF}; pg8::TailSplitOrder S; S.init(MP, 1024, G, bx, DFF, 11);
        pg8::EpiZ2 E{(const bf16_t*)(ws + WS_X1B), KIN(25), KOUT(), (float*)(ws + WS_U), S.tail_row0()};
        pg8::gemm_phase<pg8::EpiZ2, pg8::TailSplitOrder, true, true>(lds, g, S, E);
    }
    GSYNC();
    {
        const int gw = bx * 8 + wave, NGW = G * 8;
        const float* lg = KIN(26); const float* lb = KIN(27); float* const outp = KOUT();
        pg8::TailSplitOrder S7; S7.init(MP, 1024, G, bx, DFF, 11); const int ty0 = S7.split_mode ? S7.tail_row0() - 128 : (1 << 30);
        const float* part = (const float*)(KWS() + WS_U);
#define Z2ROW(r_) ((const f32x4*)((r_) >= ty0 ? part + (size_t)((r_) - ty0) * DM : outp + (size_t)(r_) * DM) + lane)
        f32x4 nv[4];
        if (gw < NB * SEQ + RS) { const f32x4* x0 = Z2ROW(gw);
#pragma unroll
            for (int j = 0; j < 4; ++j) nv[j] = x0[64 * j]; }
        for (int r = gw; r < NB * SEQ + RS; r += NGW) {
            f32x4* xr = (f32x4*)(outp + (size_t)r * DM) + lane;
            f32x4 v[4]; float s = 0.f;
#pragma unroll
            for (int j = 0; j < 4; ++j) v[j] = nv[j];
            if (r + NGW < NB * SEQ + RS) { const f32x4* xn = Z2ROW(r + NGW);
#pragma unroll
                for (int j = 0; j < 4; ++j) nv[j] = xn[64 * j]; }
            if (r >= ty0) {
                const f32x4* pr = Z2ROW(r);
                for (int pc = 1; pc < 11; ++pc) {
#pragma unroll
                    for (int j = 0; j < 4; ++j) v[j] += pr[pc * (pg8::PART_STRIDE / 4) + 64 * j]; }
            }
#pragma unroll
            for (int j = 0; j < 4; ++j) s += (v[j].x + v[j].y) + (v[j].z + v[j].w);
            const float mean = wave_sum(s) * (1.f / DM); float s2 = 0.f;
#pragma unroll
            for (int j = 0; j < 4; ++j) { v[j] = v[j] - mean; s2 += (v[j].x * v[j].x + v[j].y * v[j].y) + (v[j].z * v[j].z + v[j].w * v[j].w); }
            const float rstd = 1.f / sqrtf(wave_sum(s2) * (1.f / DM) + LN_EPS);
#pragma unroll
            for (int j = 0; j < 4; ++j) {
                const f32x4 gg = *((const f32x4*)lg + lane + 64 * j), bb = *((const f32x4*)lb + lane + 64 * j);
                xr[64 * j] = v[j] * rstd * gg + bb;
            }
        }
    }
}

extern "C" void kernel_launch(void* const* d_in, const int* in_sizes, int n_in, void* d_out, int out_size, void* d_ws, size_t ws_size, hipStream_t stream) {
    static int grid_blocks = 0;
    if (grid_blocks == 0) {
        int dev = 0, cus = 0, per_cu = 0;
        (void)hipGetDevice(&dev);
        (void)hipDeviceGetAttribute(&cus, hipDeviceAttributeMultiprocessorCount, dev);
        (void)hipFuncSetAttribute((const void*)fwd_kernel, hipFuncAttributeMaxDynamicSharedMemorySize, LDS_BYTES);
        (void)hipOccupancyMaxActiveBlocksPerMultiprocessor(&per_cu, (const void*)fwd_kernel, 512, LDS_BYTES);
        if (per_cu < 1) { fprintf(stderr, "kernel_launch: occupancy query returned %d\n", per_cu); per_cu = 1; }
        grid_blocks = cus * per_cu;
    }
    (void)hipMemsetAsync((unsigned char*)d_ws + WS_SMALL + SM_BAR, 0, 16384, stream);
    Params p{};
    for (int i = 0; i < 28; ++i) p.in[i] = (const float*)d_in[i];
    p.out = (float*)d_out; p.ws = (unsigned char*)d_ws;
    void* args[] = {&p};
    hipError_t e = hipLaunchCooperativeKernel((const void*)fwd_kernel, dim3(grid_blocks), dim3(512), args, LDS_BYTES, stream);
    if (e != hipSuccess) fprintf(stderr, "cooperative launch failed: %s (grid %d)\n", hipGetErrorString(e), grid_blocks);
}
```
